# Optimizing an MI355X kernel written in HIP

```python
import math
import jax, jax.numpy as jnp
from jax import lax
import numpy as np

D_MODEL = 4096
BATCH = 4
SEQ = 4096
DEPTH = 2

CHUNK = 64
N_META = 16
Q_BLOCK = 128
MIX_WIDTH = D_MODEL
A_WIDTH = MIX_WIDTH // 2
B_WIDTH = MIX_WIDTH - A_WIDTH
A_DK = 128
A_HEADS = A_WIDTH // A_DK
A_DV = A_WIDTH // A_HEADS
B_DV = 128
B_HEADS = B_WIDTH // B_DV
B_DH = B_DV // 2
D_FF = 4 * D_MODEL
IN_COLS = 4 * A_WIDTH + 2 * (B_HEADS * 2 * B_DH) + B_HEADS * B_DV
EPS = 1e-6
MASK_VALUE = -1e30

kernel_name = "hymba_hgrn2_diffattn_chunk_causal"


def rms_norm(x, g):
    xf = x.astype(jnp.float32)
    y = xf * lax.rsqrt(jnp.mean(xf * xf, axis=-1, keepdims=True) + EPS)
    return (y * g.astype(jnp.float32)).astype(x.dtype)


def chunk_id(pos):
    return jnp.where(pos < N_META, 0, (pos - N_META) // CHUNK + 1)


def alibi_slopes(n_heads):
    h = jnp.arange(1, n_heads + 1, dtype=jnp.float32)
    return jnp.exp2(-8.0 * h / n_heads)


def hgrn2_chunk_step(S, inp):
    q, k, v, logf = inp
    C = q.shape[1]
    b = jnp.cumsum(logf, axis=1)
    causal = jnp.tril(jnp.ones((C, C), dtype=bool))
    diff = b[:, :, None] - b[:, None, :]
    decay = jnp.exp(jnp.where(causal[None, :, :, None, None], diff, -jnp.inf))
    A = jnp.einsum('bthd,bshd,btshd->bhts', q, k, decay)
    o_intra = jnp.einsum('bhts,bshe->bthe', A, v)
    o_inter = jnp.einsum('bthd,bhde->bthe', q * jnp.exp(b), S)
    b_last = b[:, -1]
    k_dec = k * jnp.exp(b_last[:, None] - b)
    S_new = jnp.exp(b_last)[..., None] * S + jnp.einsum('bshd,bshe->bhde', k_dec, v)
    return S_new, o_intra + o_inter


def hgrn2_mixer(q, fpre, i, g, lb, out_g):
    Bn, L, _ = q.shape
    f32 = jnp.float32
    qh = q.astype(f32).reshape(Bn, L, A_HEADS, A_DK)
    fh = fpre.astype(f32).reshape(Bn, L, A_HEADS, A_DK)
    vh = i.astype(f32).reshape(Bn, L, A_HEADS, A_DV)
    lbh = lb.reshape(A_HEADS, A_DK)
    f = lbh + (1.0 - lbh) * jax.nn.sigmoid(fh)
    logf = jnp.log(f)
    kh = (1.0 - lbh) * jax.nn.sigmoid(-fh)
    S0 = jnp.zeros((Bn, A_HEADS, A_DK, A_DV), f32)
    S1, o_meta = hgrn2_chunk_step(S0, (qh[:, :N_META], kh[:, :N_META], vh[:, :N_META], logf[:, :N_META]))
    n_chunks = (L - N_META) // CHUNK

    def to_chunks(t):
        t = t[:, N_META:]
        t = t.reshape(Bn, n_chunks, CHUNK, *t.shape[2:])
        return jnp.moveaxis(t, 1, 0)

    _, o_real = lax.scan(hgrn2_chunk_step, S1, (to_chunks(qh), to_chunks(kh), to_chunks(vh), to_chunks(logf)))
    o_real = jnp.moveaxis(o_real, 0, 1).reshape(Bn, L - N_META, A_HEADS, A_DV)
    o = jnp.concatenate([o_meta, o_real], axis=1)
    o = rms_norm(o, out_g).reshape(Bn, L, A_WIDTH)
    return (o * jax.nn.silu(g.astype(f32))).astype(q.dtype)


def diff_attention(q, k, v, lam, lam_init, out_g):
    Bn, L = q.shape[0], q.shape[1]
    pos = jnp.arange(L)
    kchunk = chunk_id(pos)
    slopes = alibi_slopes(B_HEADS)
    scale = 1.0 / math.sqrt(B_DH)

    def attend(qb, qposb):
        s = jnp.einsum('bqhcd,bkhcd->bchqk', qb, k).astype(jnp.float32) * scale
        dist = jnp.abs(qposb[:, None] - pos[None, :]).astype(jnp.float32)
        s = s - slopes[:, None, None] * dist
        mask = kchunk[None, :] <= chunk_id(qposb)[:, None]
        s = jnp.where(mask, s, MASK_VALUE)
        p = jax.nn.softmax(s, axis=-1)
        a = p[:, 0] - lam * p[:, 1]
        return jnp.einsum('bhqk,bkhe->bqhe', a.astype(v.dtype), v)

    o_meta = attend(q[:, :N_META], pos[:N_META])
    n_blk = (L - N_META) // Q_BLOCK
    qr = jnp.moveaxis(q[:, N_META:].reshape(Bn, n_blk, Q_BLOCK, B_HEADS, 2, B_DH), 1, 0)
    pr = pos[N_META:].reshape(n_blk, Q_BLOCK)
    o_real = lax.map(lambda a: attend(a[0], a[1]), (qr, pr))
    o_real = jnp.moveaxis(o_real, 0, 1).reshape(Bn, L - N_META, B_HEADS, B_DV)
    o = jnp.concatenate([o_meta, o_real], axis=1)
    o = rms_norm(o, out_g) * (1.0 - lam_init)
    return o.reshape(Bn, L, B_WIDTH).astype(q.dtype)


def setup_inputs(seed: int = 0) -> dict:
    key = jax.random.key(seed)
    ks = jax.random.split(key, 16)
    f32 = jnp.float32
    nrm = lambda k, shape, std: jax.random.normal(k, shape, f32) * std
    return {
        "x": nrm(ks[0], (BATCH, SEQ, D_MODEL), 1.0),
        "meta_tokens": nrm(ks[1], (N_META, D_MODEL), 1.0),
        "norm1_g": 1.0 + nrm(ks[2], (DEPTH, D_MODEL), 0.01),
        "w_in": nrm(ks[3], (DEPTH, D_MODEL, IN_COLS), D_MODEL ** -0.5),
        "hgrn_lb_raw": nrm(ks[4], (DEPTH, A_WIDTH), 0.1),
        "hgrn_out_g": 1.0 + nrm(ks[5], (DEPTH, A_DV), 0.01),
        "q_norm_g": 1.0 + nrm(ks[6], (DEPTH, 2, B_DH), 0.01),
        "k_norm_g": 1.0 + nrm(ks[7], (DEPTH, 2, B_DH), 0.01),
        "diff_lambda": nrm(ks[8], (DEPTH, 4, B_DH), 0.1),
        "diff_out_g": 1.0 + nrm(ks[9], (DEPTH, B_DV), 0.01),
        "w_out": nrm(ks[10], (DEPTH, MIX_WIDTH, D_MODEL), MIX_WIDTH ** -0.5),
        "norm2_g": 1.0 + nrm(ks[11], (DEPTH, D_MODEL), 0.01),
        "w_mlp_up": nrm(ks[12], (DEPTH, D_MODEL, D_FF), D_MODEL ** -0.5),
        "w_mlp_down": nrm(ks[13], (DEPTH, D_FF, D_MODEL), 0.5 * D_FF ** -0.5),
    }


def reference(x, meta_tokens, norm1_g, w_in, hgrn_lb_raw, hgrn_out_g, q_norm_g, k_norm_g,
              diff_lambda, diff_out_g, w_out, norm2_g, w_mlp_up, w_mlp_down):
    Bn = x.shape[0]
    meta = jnp.broadcast_to(meta_tokens.astype(x.dtype)[None], (Bn, N_META, D_MODEL))
    h = jnp.concatenate([meta, x], axis=1)
    L = h.shape[1]
    lb_all = jnp.cumsum(jax.nn.softmax(hgrn_lb_raw.astype(jnp.float32), axis=0), axis=0)
    lb_all = lb_all - lb_all[0:1]
    split_at = np.cumsum([A_WIDTH, A_WIDTH, A_WIDTH, A_WIDTH,
                          B_HEADS * 2 * B_DH, B_HEADS * 2 * B_DH])
    for layer in range(DEPTH):
        u = rms_norm(h, norm1_g[layer])
        proj = u @ w_in[layer]
        a_q, a_f, a_i, a_g, b_q, b_k, b_v = jnp.split(proj, split_at, axis=-1)
        o_a = hgrn2_mixer(a_q, a_f, a_i, a_g, lb_all[layer], hgrn_out_g[layer])
        bq = rms_norm(b_q.reshape(Bn, L, B_HEADS, 2, B_DH), q_norm_g[layer])
        bk = rms_norm(b_k.reshape(Bn, L, B_HEADS, 2, B_DH), k_norm_g[layer])
        bv = b_v.reshape(Bn, L, B_HEADS, B_DV)
        lp = diff_lambda[layer].astype(jnp.float32)
        lam_init = 0.8 - 0.6 * math.exp(-0.3 * layer)
        lam = jnp.exp(jnp.sum(lp[0] * lp[1])) - jnp.exp(jnp.sum(lp[2] * lp[3])) + lam_init
        o_b = diff_attention(bq, bk, bv, lam, lam_init, diff_out_g[layer])
        h = h + jnp.concatenate([o_a, o_b], axis=-1) @ w_out[layer]
        u = rms_norm(h, norm2_g[layer])
        z = jax.nn.relu(u @ w_mlp_up[layer])
        h = h + (z * z) @ w_mlp_down[layer]
    return h[:, N_META:]
```

```cpp
#include <hip/hip_runtime.h>
#include <cstdio>
#include <cstdint>
namespace pg8 {
#define PG8_LAS __attribute__((address_space(3)))
typedef unsigned short bf16_t;
typedef short bf16x8 __attribute__((ext_vector_type(8)));
typedef float f32x4 __attribute__((ext_vector_type(4)));
typedef unsigned u32x4 __attribute__((ext_vector_type(4)));
constexpr int BM = 256, BK = 64, HALF = 128, HTB = HALF * BK * 2  , STAGE_BYTES = 8 * HTB, NXCD = 8, WGM = 8;

__host__ __device__ __forceinline__ int lds_byte(int r, int c) { const int st = (r >> 4) * 2 + (c >> 5), rr = r & 15, cc = c & 31, ob = rr * 64 + cc * 2; return st * 1024 + (ob ^ (((ob >> 9) & 1) << 5)); }
__host__ __device__ __forceinline__ void stage_rc(int b, int& R, int& C) { const int st = b / 1024, sb = b % 1024, swz = sb ^ (((sb >> 9) & 1) << 5); R = (st >> 1) * 16 + swz / 64; C = (st & 1) * 32 + (swz % 64) / 2; }
__host__ __device__ __forceinline__ int perm32(int rho) { const int n = rho >> 4, i = rho & 15; return 8 * (i >> 2) + 4 * n + (i & 3); }

struct Unit { int pm, pn; };
struct Gemm { const bf16_t* A; const bf16_t* Bt; int M, N, K; };

struct StaticOrder {
    int nM, nN, nwg, G, c;
    __host__ __device__ void init(int M, int N, int G_, int c_) { nM = M / BM; nN = N / BM; nwg = nM * nN; G = G_; c = c_; }
    __host__ __device__ bool next(int i, Unit& u) const {
        const long L = (long)i * G + c; if (L >= nwg) return false;
        int wgid = (int)L; { const int q = nwg / NXCD, r = nwg % NXCD, xcd = wgid % NXCD, off = wgid / NXCD; wgid = (xcd < r ? xcd * (q + 1) : r * (q + 1) + (xcd - r) * q) + off; }
        const int nig = WGM * nN, gid = wgid / nig, fm = gid * WGM, gsz = (nM - fm) < WGM ? (nM - fm) : WGM;
        u.pm = fm + ((wgid % nig) % gsz); u.pn = (wgid % nig) / gsz; return true;
    }
    __device__ __forceinline__ void a_ready(const Unit&) const {}
    __device__ __forceinline__ void done(const Unit&) const {}
};

__device__ __forceinline__ unsigned cvt_pk_bf16(float lo, float hi) { unsigned r; asm volatile("v_cvt_pk_bf16_f32 %0, %1, %2" : "=v"(r) : "v"(lo), "v"(hi)); return r; }
typedef float f32x2 __attribute__((ext_vector_type(2)));
constexpr int E_D = 4096, E_MR = 16384, E_MROWS = 16400;
constexpr float E_EPS = 1e-6f;
__device__ __forceinline__ u32x4 pack8(const f32x4 a, const f32x4 b) { u32x4 w; w.x = cvt_pk_bf16(a[0], a[1]); w.y = cvt_pk_bf16(a[2], a[3]); w.z = cvt_pk_bf16(b[0], b[1]); w.w = cvt_pk_bf16(b[2], b[3]); return w; }
struct EpiIn {
    static constexpr bool PERM = true, AFTER_DRAIN = false;
    bf16_t* P; int ldp; const float* ssq; const float* gq; const float* gk; float qscale;
    __device__ __forceinline__ void operator()(const f32x4 (&acc)[2][2][4][2], const Unit& u, int wr, int wc, int fr, int fq) const {
        const int row0 = u.pm * BM + wr * 64 + fr;
        const int sect = u.pn >> 3;
        if (sect == 4 || sect == 5) {
            const float* g = (sect == 4 ? gq : gk) + (wc & 1) * 64; const float sc = sect == 4 ? qscale : 1.f;
            f32x4 gv[2][2];
#pragma unroll
            for (int bj = 0; bj < 2; ++bj)
#pragma unroll
                for (int n = 0; n < 2; ++n) gv[bj][n] = *(const f32x4*)(g + 32 * bj + 8 * fq + 4 * n) * sc;
#pragma unroll
            for (int ai = 0; ai < 2; ++ai)
#pragma unroll
                for (int m = 0; m < 4; ++m) { const int row = row0 + ai * HALF + m * 16;
                    const float rs = __builtin_amdgcn_rsqf(ssq[row] * (1.0f / E_D) + E_EPS);
                    f32x4 v[2][2]; float ss = 0.f;
#pragma unroll
                    for (int bj = 0; bj < 2; ++bj)
#pragma unroll
                        for (int n = 0; n < 2; ++n) { v[bj][n] = acc[ai][bj][m][n] * rs; const f32x4 q = v[bj][n] * v[bj][n]; ss += (q[0] + q[1]) + (q[2] + q[3]); }
                    ss += __shfl_xor(ss, 16); ss += __shfl_xor(ss, 32);
                    const float r2 = __builtin_amdgcn_rsqf(ss * (1.0f / 64.0f) + E_EPS);
                    bf16_t* rowp = P + (size_t)row * ldp + u.pn * BM + 64 * wc + 8 * fq;
#pragma unroll
                    for (int bj = 0; bj < 2; ++bj) *(u32x4*)(rowp + 32 * bj) = pack8(v[bj][0] * r2 * gv[bj][0], v[bj][1] * r2 * gv[bj][1]); }
        } else {
#pragma unroll
            for (int ai = 0; ai < 2; ++ai)
#pragma unroll
                for (int m = 0; m < 4; ++m) { const int row = row0 + ai * HALF + m * 16;
                    const float rs = __builtin_amdgcn_rsqf(ssq[row] * (1.0f / E_D) + E_EPS);
                    bf16_t* rowp = P + (size_t)row * ldp + u.pn * BM + 32 * wc + 8 * fq;
#pragma unroll
                    for (int bj = 0; bj < 2; ++bj) *(u32x4*)(rowp + bj * HALF) = pack8(acc[ai][bj][m][0] * rs, acc[ai][bj][m][1] * rs); }
        }
    }
};
struct EpiUp {
    static constexpr bool PERM = true, AFTER_DRAIN = false;
    bf16_t* Z; int ldz; const float* ssq;
    __device__ __forceinline__ void operator()(const f32x4 (&acc)[2][2][4][2], const Unit& u, int wr, int wc, int fr, int fq) const {
        const int row0 = u.pm * BM + wr * 64 + fr;
#pragma unroll
        for (int ai = 0; ai < 2; ++ai)
#pragma unroll
            for (int m = 0; m < 4; ++m) { const int row = row0 + ai * HALF + m * 16;
                const float rs = __builtin_amdgcn_rsqf(ssq[row] * (1.0f / E_D) + E_EPS);
                bf16_t* rowp = Z + (size_t)row * ldz + u.pn * BM + 32 * wc + 8 * fq;
#pragma unroll
                for (int bj = 0; bj < 2; ++bj) { f32x4 a = acc[ai][bj][m][0] * rs, b = acc[ai][bj][m][1] * rs;
                    a = __builtin_elementwise_max(a, (f32x4){0.f, 0.f, 0.f, 0.f}); b = __builtin_elementwise_max(b, (f32x4){0.f, 0.f, 0.f, 0.f});
                    *(u32x4*)(rowp + bj * HALF) = pack8(a * a, b * b); } }
    }
};
struct EpiRes {
    static constexpr bool PERM = true, AFTER_DRAIN = false;
    const float* base_real; const float* base_meta;
    float* outf; bf16_t* outb; float* ssq;
    __device__ __forceinline__ void operator()(const f32x4 (&acc)[2][2][4][2], const Unit& u, int wr, int wc, int fr, int fq) const {
        const int row0 = u.pm * BM + wr * 64 + fr; const int col0 = u.pn * BM + 32 * wc + 8 * fq;
#pragma unroll
        for (int ai = 0; ai < 2; ++ai)
#pragma unroll
            for (int m = 0; m < 4; ++m) { const int row = row0 + ai * HALF + m * 16; const bool ok = row < E_MROWS;
                const float* bp = (row < E_MR ? base_real + (size_t)row * E_D : base_meta + (size_t)(ok ? row - E_MR : 0) * E_D) + col0;
                float part = 0.f;
#pragma unroll
                for (int bj = 0; bj < 2; ++bj) { const f32x4 a = acc[ai][bj][m][0] + *(const f32x4*)(bp + bj * HALF), b = acc[ai][bj][m][1] + *(const f32x4*)(bp + bj * HALF + 4);
                    if (ok) { float* op = outf + (size_t)row * E_D + col0 + bj * HALF; *(f32x4*)op = a; *(f32x4*)(op + 4) = b;
                        if (outb) *(u32x4*)(outb + (size_t)row * E_D + col0 + bj * HALF) = pack8(a, b); }
                    const f32x4 qa = a * a, qb = b * b; part += ((qa[0] + qa[1]) + (qa[2] + qa[3])) + ((qb[0] + qb[1]) + (qb[2] + qb[3])); }
                if (ssq) { part += __shfl_xor(part, 16); part += __shfl_xor(part, 32); if (fq == 0 && ok) atomicAdd(ssq + row, part); }
                if (m & 1) asm volatile("" ::: "memory"); }
    }
};
template <class Epi, class Sched, bool ALIGN_EPI = false, bool SP2 = false>
__device__ __forceinline__ void gemm_phase(PG8_LAS unsigned char* lds, const Gemm g, const Sched& S, const Epi& E) {
    int tid_ = threadIdx.x; asm volatile("" : "+v"(tid_));
    const int tid = tid_, wid = __builtin_amdgcn_readfirstlane(tid >> 6), lane = tid & 63, wr = wid >> 2, wc = wid & 3, fr = lane & 15, fq = lane >> 4;
    const int K = g.K, nt = K / BK;
    unsigned voffA[2], voffB[2];
#pragma unroll
    for (int i = 0; i < 2; ++i) { int R, C; stage_rc(tid * 16 + i * 8192, R, C); const int Rb = Epi::PERM ? ((R & ~31) + perm32(R & 31)) : R;
        voffA[i] = (unsigned)(R * K + C) * 2u; voffB[i] = (unsigned)(Rb * K + C) * 2u; }
    const size_t kstep = (size_t)(BK * 2);
    const size_t hstep = (size_t)HALF * K * 2;
    const size_t tstep = 2 * hstep;
    const unsigned ldsw = (unsigned)wid * 1024u;
    const int aoff = lds_byte(wr * 64 + fr, fq * 8), boff = lds_byte(wc * 32 + fr, fq * 8);
#define PG8_SA(b, h) (((b) * 2 + (h)) * HTB)
#define PG8_SB(b, h) ((4 + (b) * 2 + (h)) * HTB)
#define PG8_STAGE(bufoff, gbase, voff) do { _Pragma("unroll") for (int _i = 0; _i < 2; ++_i) \
        __builtin_amdgcn_global_load_lds((const unsigned*)((const char*)(gbase) + (voff)[_i]), (PG8_LAS unsigned*)(lds + (bufoff) + ldsw + _i * 8192), 16, 0, 0); } while (0)
#define PG8_LDA(dst, b, h) do { _Pragma("unroll") for (int m = 0; m < 4; ++m) _Pragma("unroll") for (int k = 0; k < 2; ++k) dst[m][k] = *(const PG8_LAS bf16x8*)(lds + PG8_SA(b, h) + aoff + m * 2048 + k * 1024); } while (0)
#define PG8_LDB(dst, b, h) do { _Pragma("unroll") for (int n = 0; n < 2; ++n) _Pragma("unroll") for (int k = 0; k < 2; ++k) dst[n][k] = *(const PG8_LAS bf16x8*)(lds + PG8_SB(b, h) + boff + n * 2048 + k * 1024); } while (0)
#define PG8_MMA(ai, bj, At, Bt) do { __builtin_amdgcn_s_setprio(1); _Pragma("unroll") for (int m = 0; m < 4; ++m) _Pragma("unroll") for (int n = 0; n < 2; ++n) _Pragma("unroll") for (int k = 0; k < 2; ++k) \
        acc[ai][bj][m][n] = __builtin_amdgcn_mfma_f32_16x16x32_bf16(Bt[n][k], At[m][k], acc[ai][bj][m][n], 0, 0, 0); __builtin_amdgcn_s_setprio(0); } while (0)
#define PG8_WAIT_V(n) asm volatile("s_waitcnt vmcnt(" #n ")" ::: "memory")
#define PG8_WAIT_L(n) asm volatile("s_waitcnt lgkmcnt(" #n ")" ::: "memory")
#define PG8_BAR __builtin_amdgcn_s_barrier()
#define PG8_SCHED __builtin_amdgcn_sched_barrier(0)
    Unit cur, nxt; int ui = 0;
    if (!S.next(0, cur)) return;
    f32x4 acc[2][2][4][2];
#pragma unroll
    for (int a = 0; a < 2; ++a)
#pragma unroll
        for (int b = 0; b < 2; ++b)
#pragma unroll
            for (int m = 0; m < 4; ++m)
#pragma unroll
                for (int n = 0; n < 2; ++n) acc[a][b][m][n] = (f32x4){0.f, 0.f, 0.f, 0.f};
    bf16x8 At[4][2], B0[2][2], B1[2][2];
    const char* cA = (const char*)g.A + (size_t)cur.pm * tstep; const char* cB = (const char*)g.Bt + (size_t)cur.pn * tstep;
    S.a_ready(cur);
    if constexpr (SP2) {
        PG8_STAGE(PG8_SB(0, 0), cB, voffB); PG8_STAGE(PG8_SB(0, 1), cB + hstep, voffB); PG8_STAGE(PG8_SA(0, 0), cA, voffA); PG8_STAGE(PG8_SA(0, 1), cA + hstep, voffA);
        if (wr == 1) PG8_BAR;
        PG8_WAIT_V(2); PG8_BAR;
        PG8_STAGE(PG8_SB(1, 0), cB + kstep, voffB); PG8_STAGE(PG8_SA(1, 0), cA + kstep, voffA); PG8_STAGE(PG8_SB(1, 1), cB + hstep + kstep, voffB);
        PG8_WAIT_V(6); PG8_BAR;
    } else {
        PG8_STAGE(PG8_SB(0, 0), cB, voffB); PG8_STAGE(PG8_SA(0, 0), cA, voffA); PG8_STAGE(PG8_SB(0, 1), cB + hstep, voffB); PG8_STAGE(PG8_SA(0, 1), cA + hstep, voffA);
        if (wr == 1) PG8_BAR;
        PG8_WAIT_V(4); PG8_BAR;
        PG8_STAGE(PG8_SB(1, 0), cB + kstep, voffB); PG8_STAGE(PG8_SA(1, 0), cA + kstep, voffA); PG8_STAGE(PG8_SB(1, 1), cB + hstep + kstep, voffB);
        PG8_WAIT_V(6); PG8_BAR;
    }
    for (;;) {
        const bool has_next = S.next(ui + 1, nxt);
        const char* nA = has_next ? (const char*)g.A + (size_t)nxt.pm * tstep : cA; const char* nB = has_next ? (const char*)g.Bt + (size_t)nxt.pn * tstep : cB;
        for (int t = 0; t < nt; t += 2) {
            const bool last = (t == nt - 2);
            const char* a1 = cA + (size_t)(t + 1) * kstep;
            const char* a2 = last ? nA : cA + (size_t)(t + 2) * kstep; const char* b2 = last ? nB : cB + (size_t)(t + 2) * kstep;
            const char* a3 = a2 + kstep; const char* b3 = b2 + kstep;
            if (last && has_next) S.a_ready(nxt);
            if constexpr (SP2) {
            PG8_LDB(B0, 0, 0); PG8_LDB(B1, 0, 1); PG8_SCHED; PG8_LDA(At, 0, 0); PG8_STAGE(PG8_SA(1, 1), a1 + hstep, voffA);
            PG8_WAIT_V(8); PG8_WAIT_L(0); PG8_BAR; PG8_MMA(0, 0, At, B0); PG8_MMA(0, 1, At, B1); PG8_BAR; PG8_SCHED;
            PG8_LDA(At, 0, 1); PG8_STAGE(PG8_SB(0, 0), b2, voffB); PG8_STAGE(PG8_SB(0, 1), b2 + hstep, voffB); PG8_STAGE(PG8_SA(0, 0), a2, voffA);
            PG8_WAIT_V(8); PG8_WAIT_L(0); PG8_BAR; PG8_MMA(1, 0, At, B0); PG8_MMA(1, 1, At, B1); PG8_BAR; PG8_SCHED;
            PG8_LDB(B0, 1, 0); PG8_LDB(B1, 1, 1); PG8_SCHED; PG8_LDA(At, 1, 0); PG8_STAGE(PG8_SA(0, 1), a2 + hstep, voffA);
            PG8_WAIT_V(8); PG8_WAIT_L(0); PG8_BAR; PG8_MMA(0, 0, At, B0); PG8_MMA(0, 1, At, B1); PG8_BAR; PG8_SCHED;
            PG8_LDA(At, 1, 1); PG8_STAGE(PG8_SB(1, 0), b3, voffB); PG8_STAGE(PG8_SB(1, 1), b3 + hstep, voffB); PG8_STAGE(PG8_SA(1, 0), a3, voffA);
            PG8_WAIT_V(8); PG8_WAIT_L(0); PG8_BAR; PG8_MMA(1, 0, At, B0); PG8_MMA(1, 1, At, B1); PG8_BAR; PG8_SCHED;
            } else {
            PG8_LDB(B0, 0, 0); PG8_SCHED; PG8_LDA(At, 0, 0); PG8_STAGE(PG8_SA(1, 1), a1 + hstep, voffA);
            PG8_WAIT_L(8); PG8_BAR; PG8_WAIT_L(0); PG8_MMA(0, 0, At, B0); PG8_BAR; PG8_SCHED;
            PG8_LDB(B1, 0, 1); PG8_STAGE(PG8_SB(0, 0), b2, voffB);
            PG8_BAR; PG8_WAIT_L(0); PG8_MMA(0, 1, At, B1); PG8_BAR;
            PG8_LDA(At, 0, 1); PG8_STAGE(PG8_SA(0, 0), a2, voffA);
            PG8_BAR; PG8_WAIT_L(0); PG8_MMA(1, 0, At, B0); PG8_BAR; PG8_SCHED;
            PG8_STAGE(PG8_SB(0, 1), b2 + hstep, voffB);
            PG8_WAIT_V(6); PG8_BAR; PG8_MMA(1, 1, At, B1); PG8_BAR;
            PG8_LDB(B0, 1, 0); PG8_SCHED; PG8_LDA(At, 1, 0); PG8_STAGE(PG8_SA(0, 1), a2 + hstep, voffA);
            PG8_WAIT_L(8); PG8_BAR; PG8_WAIT_L(0); PG8_MMA(0, 0, At, B0); PG8_BAR; PG8_SCHED;
            PG8_LDB(B1, 1, 1); PG8_STAGE(PG8_SB(1, 0), b3, voffB);
            PG8_BAR; PG8_WAIT_L(0); PG8_MMA(0, 1, At, B1); PG8_BAR;
            PG8_LDA(At, 1, 1); PG8_STAGE(PG8_SA(1, 0), a3, voffA);
            PG8_BAR; PG8_WAIT_L(0); PG8_MMA(1, 0, At, B0); PG8_BAR; PG8_SCHED;
            PG8_STAGE(PG8_SB(1, 1), b3 + hstep, voffB);
            PG8_WAIT_V(6); PG8_BAR; PG8_MMA(1, 1, At, B1); PG8_BAR;
            }
        }
        if constexpr (ALIGN_EPI) { if (wr == 0) PG8_BAR; }
        if constexpr (!Epi::AFTER_DRAIN) { E(acc, cur, wr, wc, fr, fq); S.done(cur); }
        if (!has_next) break;
#pragma unroll
        for (int a = 0; a < 2; ++a)
#pragma unroll
            for (int b = 0; b < 2; ++b)
#pragma unroll
                for (int m = 0; m < 4; ++m)
#pragma unroll
                    for (int n = 0; n < 2; ++n) acc[a][b][m][n] = (f32x4){0.f, 0.f, 0.f, 0.f};
        cur = nxt; cA = nA; cB = nB; ++ui;
        if constexpr (ALIGN_EPI) { if (wr == 1) PG8_BAR; }
    }
    PG8_WAIT_V(0);
    if constexpr (!ALIGN_EPI) { if (wr == 0) PG8_BAR; }
    PG8_BAR;
    if constexpr (Epi::AFTER_DRAIN) { E.fused(acc, cur, wr, wc, fr, fq, lds, wid, lane); S.done(cur); }
#undef PG8_SA
#undef PG8_SB
#undef PG8_STAGE
#undef PG8_LDA
#undef PG8_LDB
#undef PG8_MMA
#undef PG8_WAIT_V
#undef PG8_WAIT_L
#undef PG8_BAR
#undef PG8_SCHED
}
}
constexpr int NWAVES = 8;
constexpr int DM = 4096, SEQ = 4096, BATCH = 4, NMETA = 16, DEPTH = 2;
constexpr int MR = BATCH * SEQ;
constexpr int MROWS = MR + NMETA;
constexpr int MP = 65 * 256;
constexpr int INC = 14336, FF = 16384, AW = 2048;
constexpr int C_AQ = 0, C_AF = 2048, C_AI = 4096, C_AG = 6144, C_BQ = 8192, C_BK = 10240, C_BV = 12288;
constexpr float EPS = 1e-6f;
constexpr float LOG2E = 1.4426950408889634f;
constexpr float QSCALE = 0.125f * LOG2E;

constexpr size_t MiB = 1u << 20;
constexpr size_t WS_CTL = 0, CTL_ZERO_BYTES = 2 * MiB;
constexpr size_t WS_SSQ = 1 * MiB, SSQ_STRIDE = 128 * 1024;
constexpr size_t WS_WIN = 4 * MiB;
constexpr size_t WS_WOUT = WS_WIN + (size_t)2 * INC * DM * 2;
constexpr size_t WS_WUP = WS_WOUT + (size_t)2 * DM * DM * 2;
constexpr size_t WS_WDN = WS_WUP + (size_t)2 * FF * DM * 2;
constexpr size_t WS_H = WS_WDN + (size_t)2 * FF * DM * 2;
constexpr size_t WS_HB = WS_H + (size_t)MP * DM * 4;
constexpr size_t WS_O = WS_HB + (size_t)MP * DM * 2;
constexpr size_t WS_PZ = WS_O + (size_t)MP * DM * 2;
constexpr size_t WS_OSCR = WS_PZ + (size_t)MP * FF * 2;
constexpr size_t WS_END = WS_OSCR + (size_t)MP * AW * 4;
static_assert(WS_END <= (size_t)2048 * MiB, "d_ws map");
constexpr int CW_TMO = 0, CW_CODE = 1;
constexpr int CW_BAR = 4096;
constexpr int MAX_LAUNCH = 16;

constexpr int RING_OFF = 0, RING_BYTES = 131072;
constexpr int LDSCTL_OFF = RING_BYTES, MISC_OFF = LDSCTL_OFF + 320;
constexpr int LDS_BYTES = 147456;
#define GAS __attribute__((address_space(1)))
#define LAS __attribute__((address_space(3)))
typedef unsigned short bf16;
typedef unsigned v4u __attribute__((ext_vector_type(4)));
typedef float f32x4 __attribute__((ext_vector_type(4)));
typedef short bf16x8 __attribute__((ext_vector_type(8)));
typedef GAS unsigned gu32;
typedef GAS unsigned long long gu64;
#define RLX_AGENT __ATOMIC_RELAXED, __HIP_MEMORY_SCOPE_AGENT
#define LDS_WAIT() asm volatile("s_waitcnt lgkmcnt(0)" ::: "memory")
#define VM_WAIT() asm volatile("s_waitcnt vmcnt(0)" ::: "memory")
__device__ __forceinline__ unsigned long long rt() { return __builtin_amdgcn_s_memrealtime(); }
__device__ __forceinline__ unsigned f2bf(float f) { unsigned u = __builtin_bit_cast(unsigned, f); return (u + 0x7fffu + ((u >> 16) & 1u)) >> 16; }
__device__ __forceinline__ unsigned pk2(float lo, float hi) { return f2bf(lo) | (f2bf(hi) << 16); }

#define XB_TMO      128
#define XB_XCNT(j)  (256  + 64 * (j))
#define XB_XSUB(j)  (1280 + 64 * (j))
#define XB_XGEN(j)  (2304 + 64 * (j))
#define XB_TOP      3328
#define XB_TOPGEN   3392
#define XCD_BAR_WORDS 3456
#define XB_SPIN_CAP (1u << 18)

__device__ __forceinline__ unsigned xb_ld(unsigned* p)              { return __hip_atomic_load(p, __ATOMIC_RELAXED, __HIP_MEMORY_SCOPE_AGENT); }
__device__ __forceinline__ unsigned xb_add(unsigned* p, unsigned v) { return __hip_atomic_fetch_add(p, v, __ATOMIC_RELAXED, __HIP_MEMORY_SCOPE_AGENT); }
__device__ __forceinline__ unsigned xb_xcc_id() { return (unsigned)__builtin_amdgcn_s_getreg((3 << 11) | 20) & 0xFu; }
#define XB_SPIN(cond, bar) do { unsigned _sp = 0; while (cond) { __builtin_amdgcn_s_sleep(1); \
    if ((++_sp & 255u) == 0u) { if (xb_ld(&(bar)[XB_TMO])) break; if (_sp > XB_SPIN_CAP) { atomicAdd(&(bar)[XB_TMO], 1u); break; } } } } while (0)

struct XcdBarrier {
    unsigned* bar; unsigned x;
    volatile LAS unsigned* st;
};

__device__ __forceinline__ XcdBarrier xcd_barrier_post(unsigned* bar, volatile LAS unsigned* st) {
    XcdBarrier b; b.bar = bar; b.x = xb_xcc_id(); b.st = st;
    if (threadIdx.x == 0) (void)xb_add(&bar[XB_XCNT(b.x)], 1u);
    return b;
}
__device__ __forceinline__ void xcd_barrier_complete(unsigned* bar, unsigned x, unsigned& nloc, unsigned& nx) {
    const unsigned G = gridDim.x * gridDim.y * gridDim.z;
    unsigned sum, cnt, mine, sp = 0u;
    for (;;) {
        sum = 0u; cnt = 0u; mine = 0u;
#pragma unroll
        for (unsigned j = 0; j < 16; ++j) { const unsigned c = xb_ld(&bar[XB_XCNT(j)]); sum += c; cnt += (c > 0u) ? 1u : 0u; mine = (j == x) ? c : mine; }
        if (sum == G) break;
        __builtin_amdgcn_s_sleep(1);
        if ((++sp & 255u) == 0u) { if (xb_ld(&bar[XB_TMO])) break; if (sp > XB_SPIN_CAP) { atomicAdd(&bar[XB_TMO], 1u); break; } }
    }
    nloc = mine > 0u ? mine : 1u; nx = cnt > 0u ? cnt : 1u;
}

__device__ __forceinline__ void xcd_barrier(const XcdBarrier& b) {
    asm volatile("s_waitcnt vmcnt(0)" ::: "memory");
    __syncthreads();
    if (threadIdx.x == 0) {
        unsigned* bar = b.bar;
        __builtin_amdgcn_s_waitcnt(0);
        unsigned nloc = b.st[0], nx = b.st[1];
        if (nloc == 0u) { xcd_barrier_complete(bar, b.x, nloc, nx); b.st[0] = nloc; b.st[1] = nx; }
        const unsigned old = xb_add(&bar[XB_XSUB(b.x)], 1u);
        const unsigned gen = old / nloc;
        if (old + 1u == (gen + 1u) * nloc) {
            __builtin_amdgcn_fence(__ATOMIC_RELEASE, "agent");
            asm volatile("s_waitcnt vmcnt(0)" ::: "memory");
            const unsigned og = xb_add(&bar[XB_TOP], 1u);
            const unsigned tg = og / nx;
            if (og + 1u == (tg + 1u) * nx) xb_add(&bar[XB_TOPGEN], 1u);
            else XB_SPIN(xb_ld(&bar[XB_TOPGEN]) == tg, bar);
            __builtin_amdgcn_fence(__ATOMIC_ACQUIRE, "agent");
            xb_add(&bar[XB_XGEN(b.x)], 1u);
            asm volatile("s_waitcnt vmcnt(0)" ::: "memory");
        } else {
            XB_SPIN(xb_ld(&bar[XB_XGEN(b.x)]) == gen, bar);
            __builtin_amdgcn_fence(__ATOMIC_ACQUIRE, "agent");
            asm volatile("s_waitcnt vmcnt(0)" ::: "memory");
        }
    }
    __syncthreads();
}
static_assert((CW_BAR + MAX_LAUNCH * XCD_BAR_WORDS) * 4 <= (int)WS_SSQ, "CTL words");
struct Frame {
    LAS unsigned char* lds;
    volatile LAS unsigned* MISC;
    gu32* ctl;
    int tid, lane, wave;
    int vcu, G;
};
__device__ __forceinline__ float wave_sum(float v) {
#pragma unroll
    for (int o = 1; o < 64; o <<= 1) v += __shfl_xor(v, o);
    return v;
}
__device__ __forceinline__ float wave_max(float v) {
#pragma unroll
    for (int o = 1; o < 64; o <<= 1) v = fmaxf(v, __shfl_xor(v, o));
    return v;
}
__device__ __forceinline__ float bf2f(unsigned short b) { return __uint_as_float((unsigned)b << 16); }
__device__ __forceinline__ float sigmoidf_(float x) { return 1.0f / (1.0f + __expf(-x)); }

__device__ __forceinline__ void p0_transpose_item(const float* W, int K, int N, bf16* WT, const float* g, int perm_lo, int perm_hi, LAS float* scr, int item, int lane) {
    const int nblk = N / 32, kb = item / nblk, nb = item % nblk, k0 = 64 * kb, n0 = 32 * nb;
#pragma unroll 8
    for (int i = 0; i < 32; ++i) { const int kk = 2 * i + (lane >> 5); const float gg = g ? g[k0 + kk] : 1.0f; scr[kk * 33 + (lane & 31)] = W[(size_t)(k0 + kk) * N + n0 + (lane & 31)] * gg; }
    LDS_WAIT(); asm volatile("" ::: "memory");
    int n0d = n0;
    if (n0 >= perm_lo && n0 < perm_hi) { const int blk = (n0 & 255) >> 5, wc = blk >> 1, bj = blk & 1; n0d = (n0 & ~255) + 32 * (4 * bj + wc); }
    const int c = lane & 7;
#pragma unroll
    for (int j = 0; j < 4; ++j) { const int n = (lane >> 3) + 8 * j; const LAS float* s = scr + (8 * c) * 33 + n;
        v4u o; o.x = pk2(s[0 * 33], s[1 * 33]); o.y = pk2(s[2 * 33], s[3 * 33]); o.z = pk2(s[4 * 33], s[5 * 33]); o.w = pk2(s[6 * 33], s[7 * 33]);
        *(GAS v4u*)(WT + (size_t)(n0d + n) * K + k0 + 8 * c) = o; }
    LDS_WAIT(); asm volatile("" ::: "memory");
}
__device__ __forceinline__ void row_to_bf16_ssq(const float* xrow, bf16* orow, float* ssq, int lane) {
    const GAS f32x4* xr = (const GAS f32x4*)xrow + lane;
    GAS unsigned long long* o8 = (GAS unsigned long long*)orow + lane;
    float s = 0.f;
#pragma unroll
    for (int j = 0; j < 16; ++j) { const f32x4 v = xr[64 * j]; s += (v.x * v.x + v.y * v.y) + (v.z * v.z + v.w * v.w);
        o8[64 * j] = (unsigned long long)pk2(v.x, v.y) | ((unsigned long long)pk2(v.z, v.w) << 32); }
    s = wave_sum(s);
    if (lane == 0) *ssq = s;
}
__device__ __forceinline__ void hgrn_ref_chain(Frame& F, const bf16* P, float* OSCR, const float* lbraw, int layer) {
    int tid_ = threadIdx.x; asm volatile("" : "+v"(tid_)); const int lane = tid_ & 63;
    if (__builtin_amdgcn_readfirstlane(tid_ >> 6) != 0) return;
    LAS float* gl = (LAS float*)(F.lds + RING_OFF);
    const int e = lane & 31, dh = lane >> 5;
    for (int w = F.vcu; w < 256; w += F.G) {
        const int b = w >> 6, h = (w >> 2) & 15, eq = w & 3;
        float lb[2];
#pragma unroll
        for (int dd = 0; dd < 2; ++dd) { const int c = h * 128 + lane + 64 * dd; lb[dd] = layer == 0 ? 0.f : 1.0f / (1.0f + __expf(lbraw[c] - lbraw[AW + c])); }
        float S[64];
#pragma unroll
        for (int i = 0; i < 64; ++i) S[i] = 0.f;
        for (int t0 = 0; t0 < NMETA + SEQ; t0 += 16) {
            for (int tt = 0; tt < 16; ++tt) { const int pos = t0 + tt; const size_t row = pos < NMETA ? (size_t)(MR + pos) : (size_t)b * SEQ + pos - NMETA;
#pragma unroll
                for (int dd = 0; dd < 2; ++dd) { const int d = lane + 64 * dd; const float fh = bf2f(P[row * INC + C_AF + h * 128 + d]), q = bf2f(P[row * INC + C_AQ + h * 128 + d]);
                    const float sg = 1.0f / (1.0f + __expf(-fh)), sgn = 1.0f / (1.0f + __expf(fh));
                    gl[(0 * 16 + tt) * 128 + d] = lb[dd] + (1.0f - lb[dd]) * sg; gl[(1 * 16 + tt) * 128 + d] = (1.0f - lb[dd]) * sgn; gl[(2 * 16 + tt) * 128 + d] = q; } }
            LDS_WAIT(); asm volatile("" ::: "memory");
            for (int tt = 0; tt < 16; ++tt) { const int pos = t0 + tt; const size_t row = pos < NMETA ? (size_t)(MR + pos) : (size_t)b * SEQ + pos - NMETA;
                const float v = bf2f(P[row * INC + C_AI + h * 128 + eq * 32 + e]); float acc = 0.f;
                const LAS f32x4* f4 = (const LAS f32x4*)(gl + (0 * 16 + tt) * 128 + dh * 64); const LAS f32x4* k4 = (const LAS f32x4*)(gl + (1 * 16 + tt) * 128 + dh * 64); const LAS f32x4* q4 = (const LAS f32x4*)(gl + (2 * 16 + tt) * 128 + dh * 64);
#pragma unroll
                for (int j = 0; j < 16; ++j) { const f32x4 f = f4[j], k = k4[j], q = q4[j];
#pragma unroll
                    for (int i = 0; i < 4; ++i) { S[4 * j + i] = f[i] * S[4 * j + i] + k[i] * v; acc += q[i] * S[4 * j + i]; } }
                acc += __shfl_xor(acc, 32);
                if (dh == 0 && (pos >= NMETA || b == 0)) OSCR[row * AW + h * 128 + eq * 32 + e] = acc; }
            LDS_WAIT(); asm volatile("" ::: "memory");
        }
    }
}
__device__ __forceinline__ void hgrn_ref_norm(Frame& F, const bf16* P, const float* OSCR, bf16* O, const float* og) {
    int tid_ = threadIdx.x; asm volatile("" : "+v"(tid_)); const int lane = tid_ & 63, wave = __builtin_amdgcn_readfirstlane(tid_ >> 6);
    const int gw = F.vcu * NWAVES + wave, NGW = F.G * NWAVES;
    for (int idx = gw; idx < MROWS * 16; idx += NGW) { const size_t row = idx >> 4; const int h = idx & 15, e0 = 2 * lane;
        const float x0 = OSCR[row * AW + h * 128 + e0], x1 = OSCR[row * AW + h * 128 + e0 + 1];
        const float ss = wave_sum(x0 * x0 + x1 * x1), r = 1.0f / sqrtf(ss * (1.0f / 128.0f) + EPS);
        const float g0 = bf2f(P[row * INC + C_AG + h * 128 + e0]), g1 = bf2f(P[row * INC + C_AG + h * 128 + e0 + 1]);
        const float y0 = x0 * r * og[e0] * (g0 / (1.0f + __expf(-g0))), y1 = x1 * r * og[e0 + 1] * (g1 / (1.0f + __expf(-g1)));
        *(GAS unsigned*)(O + row * DM + h * 128 + e0) = pk2(y0, y1); }
}
__device__ __forceinline__ void attn_ref(Frame& F, const bf16* P, bf16* O, const float* lp, const float* og, int layer, int u_lo, int u_hi) {
    LAS float* qf = (LAS float*)(F.lds + RING_OFF); LAS float* sc = qf + 128; LAS float* red = sc + 2 * 4112; LAS float* pvr = red + 64;
    int tid_ = threadIdx.x; asm volatile("" : "+v"(tid_)); const int tid = tid_, lane = tid & 63, wave = __builtin_amdgcn_readfirstlane(tid >> 6);
    const float lam_init = 0.8f - 0.6f * __expf(-0.3f * (float)layer);
    float lam; { const float a = wave_sum(lp[lane] * lp[64 + lane]), c = wave_sum(lp[128 + lane] * lp[192 + lane]); lam = __expf(a) - __expf(c) + lam_init; }
    for (int unit = u_lo + F.vcu; unit < u_hi; unit += F.G) {
        const int row = unit >> 4, h = unit & 15; const bool meta = row >= MR; const int b = (row >> 12) & 3, t = row & 4095;
        const int qpos = meta ? row - MR : NMETA + t, nk = meta ? NMETA : NMETA + 64 * ((t >> 6) + 1);
        const float slope2 = exp2f(-0.5f * (float)(h + 1)) * LOG2E;
        if (tid < 128) qf[tid] = bf2f(P[(size_t)row * INC + C_BQ + h * 128 + tid]);
        __syncthreads();
        float m0 = -3.0e38f, m1 = -3.0e38f;
        for (int kp = tid; kp < nk; kp += 512) { const size_t krow = kp < NMETA ? (size_t)(MR + kp) : (size_t)b * SEQ + kp - NMETA; const bf16* kr = P + krow * INC + C_BK + h * 128;
            float s0 = 0.f, s1 = 0.f;
#pragma unroll
            for (int j = 0; j < 8; ++j) { const v4u a = *(const GAS v4u*)(kr + 8 * j), c = *(const GAS v4u*)(kr + 64 + 8 * j);
#pragma unroll
                for (int i = 0; i < 4; ++i) { s0 += qf[8 * j + 2 * i] * __uint_as_float(a[i] << 16) + qf[8 * j + 2 * i + 1] * __uint_as_float(a[i] & 0xffff0000u);
                                              s1 += qf[64 + 8 * j + 2 * i] * __uint_as_float(c[i] << 16) + qf[64 + 8 * j + 2 * i + 1] * __uint_as_float(c[i] & 0xffff0000u); } }
            const float bias = slope2 * fabsf((float)(qpos - kp)); s0 -= bias; s1 -= bias; sc[kp] = s0; sc[4112 + kp] = s1; m0 = fmaxf(m0, s0); m1 = fmaxf(m1, s1); }
        m0 = wave_max(m0); m1 = wave_max(m1); if (lane == 0) { red[wave] = m0; red[8 + wave] = m1; }
        __syncthreads();
        m0 = red[0]; m1 = red[8];
#pragma unroll
        for (int i = 1; i < 8; ++i) { m0 = fmaxf(m0, red[i]); m1 = fmaxf(m1, red[8 + i]); }
        float l0 = 0.f, l1 = 0.f;
        for (int kp = tid; kp < nk; kp += 512) { const float p0 = exp2f(sc[kp] - m0), p1 = exp2f(sc[4112 + kp] - m1); sc[kp] = p0; sc[4112 + kp] = p1; l0 += p0; l1 += p1; }
        l0 = wave_sum(l0); l1 = wave_sum(l1); if (lane == 0) { red[16 + wave] = l0; red[24 + wave] = l1; }
        __syncthreads();
        l0 = 0.f; l1 = 0.f;
#pragma unroll
        for (int i = 0; i < 8; ++i) { l0 += red[16 + i]; l1 += red[24 + i]; }
        { const int c = tid >> 8, kq = (tid >> 6) & 3, ep = tid & 63; float a0 = 0.f, a1 = 0.f;
            for (int kp = kq; kp < nk; kp += 4) { const size_t krow = kp < NMETA ? (size_t)(MR + kp) : (size_t)b * SEQ + kp - NMETA;
                const unsigned vv = *(const GAS unsigned*)(P + krow * INC + C_BV + h * 128 + 2 * ep); const float p = sc[c * 4112 + kp];
                a0 += p * __uint_as_float(vv << 16); a1 += p * __uint_as_float(vv & 0xffff0000u); }
            pvr[(c * 4 + kq) * 128 + 2 * ep] = a0; pvr[(c * 4 + kq) * 128 + 2 * ep + 1] = a1; }
        __syncthreads();
        float o = 0.f;
        if (tid < 128) { float o0 = 0.f, o1 = 0.f;
#pragma unroll
            for (int kq = 0; kq < 4; ++kq) { o0 += pvr[kq * 128 + tid]; o1 += pvr[(4 + kq) * 128 + tid]; }
            o = o0 / l0 - lam * (o1 / l1);
            const float ss = wave_sum(o * o); if (lane == 0) red[32 + wave] = ss; }
        __syncthreads();
        if (tid < 128) { const float ss = red[32] + red[33]; const float y = o * (1.0f / sqrtf(ss * (1.0f / 128.0f) + EPS)) * og[tid] * (1.0f - lam_init);
            O[(size_t)row * DM + AW + h * 128 + tid] = (bf16)f2bf(y); }
        __syncthreads();
    }
}
namespace fa {
typedef short bf16x8 __attribute__((ext_vector_type(8)));
typedef short s16x4 __attribute__((ext_vector_type(4)));
typedef float f32x16 __attribute__((ext_vector_type(16)));
typedef unsigned u32x4 __attribute__((ext_vector_type(4)));
typedef float f32x2_t __attribute__((ext_vector_type(2))); typedef __bf16 bf16x2_t __attribute__((ext_vector_type(2)));
typedef short v4i16_t __attribute__((ext_vector_type(4)));
constexpr int SLOTB = 32768, NSLOT = 3;
constexpr int L_WSF = NSLOT * SLOTB;
constexpr int L_X = 0, L_OST = 65536;
constexpr float THR = 6.0f;
__device__ __forceinline__ int CR(int r) { return (r & 3) + 8 * (r >> 2); }
__device__ __forceinline__ void glds16(const void* gsrc, unsigned lds_dst) { unsigned keep;
    asm volatile("s_mov_b32 %0, m0\n\ts_mov_b32 m0, %2\n\ts_nop 0\n\tglobal_load_lds_dwordx4 %1, off\n\ts_mov_b32 m0, %0" : "=&s"(keep) : "v"(gsrc), "s"(lds_dst) : "memory"); }
__device__ __forceinline__ unsigned cvtpk(float lo, float hi) { f32x2_t v = {lo, hi}; bf16x2_t b = __builtin_convertvector(v, bf16x2_t); return __builtin_bit_cast(unsigned, b); }
__device__ __forceinline__ s16x4 vtr(const LAS char* p) { return __builtin_bit_cast(s16x4, __builtin_amdgcn_ds_read_tr16_b64_v4i16((LAS v4i16_t*)p)); }
__device__ __forceinline__ float hmax32(float v) { auto rr = __builtin_amdgcn_permlane32_swap(__float_as_uint(v), __float_as_uint(v), false, false); return fmaxf(__uint_as_float(rr[0]), __uint_as_float(rr[1])); }
__device__ __forceinline__ float hsum32(float v) { auto rr = __builtin_amdgcn_permlane32_swap(__float_as_uint(v), __float_as_uint(v), false, false); return __uint_as_float(rr[0]) + __uint_as_float(rr[1]); }
#define FA_WAIT_BAR(N) asm volatile("s_waitcnt vmcnt(" #N ") lgkmcnt(0)\n\ts_barrier" ::: "memory")

__device__ __forceinline__ void attn_unit(const bf16* P, bf16* O, int b, int h, int qb, float lam, float lam_init, const float* og, LAS unsigned char* lds) {
    int tid_ = threadIdx.x; asm volatile("" : "+v"(tid_));
    const int lane = tid_ & 63, r32 = lane & 31, hi = lane >> 5, wid = __builtin_amdgcn_readfirstlane(tid_ >> 6), c = wid >> 2, rg = wid & 3;
    const float slope2 = __uint_as_float(__builtin_amdgcn_readfirstlane(__float_as_uint(exp2f(-0.5f * (float)(h + 1)) * LOG2E)));
    const float sl2 = 2.f * slope2, sl3 = 3.f * slope2, sl8 = 8.f * slope2, sl16 = 16.f * slope2, sl24 = 24.f * slope2, sl32 = 32.f * slope2;
    const unsigned lds0 = (unsigned)(uintptr_t)lds;
    const int NT = 2 * qb + 3, jown = 2 * qb + (rg >> 1);
    const size_t rowb = (size_t)b * SEQ;
    const float qposl = (float)(NMETA + qb * 128 + rg * 32 + r32);
#define FA_DMA(i_) do { const int i__ = (i_); const bool meta__ = (i__ == NT - 1); const int j__ = 2 * qb + 1 - i__; const unsigned sl__ = lds0 + (unsigned)((i__ % NSLOT) * SLOTB); \
        const size_t rk__ = meta__ ? (size_t)(MR + (lane & 15)) : rowb + 64 * j__ + lane; \
        glds16(P + rk__ * INC + C_BK + h * 128 + wid * 8, (unsigned)__builtin_amdgcn_readfirstlane(sl__ + wid * 1024)); \
        glds16(P + rk__ * INC + C_BK + h * 128 + 64 + wid * 8, (unsigned)__builtin_amdgcn_readfirstlane(sl__ + 8192 + wid * 1024)); \
        _Pragma("unroll") for (int pp = 0; pp < 2; ++pp) { const int pc = 2 * wid + pp, d0 = pc >> 2, ks = pc & 3, kv = 16 * ks + (lane >> 2); \
            const size_t rv__ = meta__ ? (size_t)(MR + (kv & 15)) : rowb + 64 * j__ + kv; \
            glds16(P + rv__ * INC + C_BV + h * 128 + d0 * 32 + (lane & 3) * 8, (unsigned)__builtin_amdgcn_readfirstlane(sl__ + 16384 + pc * 1024)); } } while (0)
    asm volatile("s_waitcnt vmcnt(0)" ::: "memory");
    bf16x8 qf[4];
    { const bf16* Qw = P + (rowb + qb * 128 + rg * 32 + r32) * INC + C_BQ + h * 128 + c * 64 + hi * 8;
#pragma unroll
      for (int d0 = 0; d0 < 4; ++d0) qf[d0] = *(const GAS bf16x8*)(Qw + d0 * 16); }
    FA_DMA(0); FA_DMA(1);
    f32x16 o[4];
#pragma unroll
    for (int d0 = 0; d0 < 4; ++d0)
#pragma unroll
        for (int r = 0; r < 16; ++r) o[d0][r] = 0.f;
    float mhat = -32.f, lsum = 0.f;
    LAS float* wsf = (LAS float*)(lds + L_WSF) + wid * 64;
    const LAS char* ldsc = (const LAS char*)lds;
    for (int i = 0; i < NT; ++i) {
        if (i + 1 < NT) FA_WAIT_BAR(4); else FA_WAIT_BAR(0);
        if (i + 2 < NT) FA_DMA(i + 2);
        const bool meta = (i == NT - 1); const int j = 2 * qb + 1 - i;
        if (!meta && j > jown) continue;
        const bool general = meta || (j == jown);
        const int slot = (i % NSLOT) * SLOTB;
        const LAS char* Ks = ldsc + slot + c * 8192 + hi * 1024 + r32 * 16;
        const float kvpos = meta ? 0.f : (float)(NMETA + 64 * j);
        f32x16 p0, p1;
        if (!general) { const float base = slope2 * (kvpos + (float)(4 * hi) - qposl) - mhat;
            const float t0 = base, t1 = base + slope2, t2 = base + sl2, t3 = base + sl3;
            p0[0] = t0; p0[1] = t1; p0[2] = t2; p0[3] = t3;
            p0[4] = t0 + sl8; p0[5] = t1 + sl8; p0[6] = t2 + sl8; p0[7] = t3 + sl8;
            p0[8] = t0 + sl16; p0[9] = t1 + sl16; p0[10] = t2 + sl16; p0[11] = t3 + sl16;
            p0[12] = t0 + sl24; p0[13] = t1 + sl24; p0[14] = t2 + sl24; p0[15] = t3 + sl24;
#pragma unroll
            for (int r = 0; r < 16; ++r) p1[r] = p0[r] + sl32; }
        else {
#pragma unroll
            for (int r = 0; r < 16; ++r) { p0[r] = 0.f; p1[r] = 0.f; } }
#pragma unroll
        for (int d0 = 0; d0 < 4; ++d0) { const bf16x8 k0 = *(const LAS bf16x8*)(Ks + d0 * 2048), k1 = *(const LAS bf16x8*)(Ks + d0 * 2048 + 512);
            p0 = __builtin_amdgcn_mfma_f32_32x32x16_bf16(k0, qf[d0], p0, 0, 0, 0); p1 = __builtin_amdgcn_mfma_f32_32x32x16_bf16(k1, qf[d0], p1, 0, 0, 0); }
        if (general) {
#pragma unroll
            for (int r = 0; r < 16; ++r) { const float dq = qposl - kvpos - (float)(4 * hi);
                p0[r] = p0[r] - slope2 * fabsf(dq - (float)CR(r)) - mhat; p1[r] = p1[r] - slope2 * fabsf(dq - (float)(CR(r) + 32)) - mhat; }
            if (meta) {
#pragma unroll
                for (int r = 0; r < 16; ++r) { if (4 * hi + CR(r) >= NMETA) p0[r] = -1.0e30f; p1[r] = -1.0e30f; } }
        }
        float rm = fmaxf(p0[0], p1[0]);
#pragma unroll
        for (int r = 1; r < 16; ++r) rm = fmaxf(rm, fmaxf(p0[r], p1[r]));
        rm = hmax32(rm);
        if (__any(rm > THR)) { const float dl = fmaxf(rm, 0.f); mhat += dl;
#pragma unroll
            for (int r = 0; r < 16; ++r) { p0[r] -= dl; p1[r] -= dl; }
            const float f = exp2f(-dl); lsum *= f; if (hi == 0) wsf[r32] = f;
            LDS_WAIT();
#pragma unroll
            for (int r = 0; r < 16; ++r) { const float fr = wsf[CR(r) + 4 * hi];
#pragma unroll
                for (int d0 = 0; d0 < 4; ++d0) o[d0][r] *= fr; }
            LDS_WAIT(); }
        float ls = 0.f;
#pragma unroll
        for (int r = 0; r < 16; ++r) { p0[r] = __builtin_amdgcn_exp2f(p0[r]); p1[r] = __builtin_amdgcn_exp2f(p1[r]); ls += p0[r] + p1[r]; }
        lsum += ls;
        bf16x8 pa[4];
#pragma unroll
        for (int s = 0; s < 2; ++s) { u32x4 w0, w1;
#pragma unroll
            for (int q = 0; q < 4; ++q) { w0[q] = cvtpk(p0[8 * s + 2 * q], p0[8 * s + 2 * q + 1]); w1[q] = cvtpk(p1[8 * s + 2 * q], p1[8 * s + 2 * q + 1]); }
            pa[s] = __builtin_bit_cast(bf16x8, w0); pa[2 + s] = __builtin_bit_cast(bf16x8, w1); }
        const LAS char* Vs = ldsc + slot + 16384 + ((lane >> 4) & 1) * 32 + (lane & 3) * 8 + (4 * hi + ((lane & 15) >> 2)) * 64;
#pragma unroll
        for (int d0 = 0; d0 < 4; ++d0)
#pragma unroll
            for (int s = 0; s < 4; ++s) { const s16x4 lo = vtr(Vs + d0 * 4096 + s * 1024), hh = vtr(Vs + d0 * 4096 + s * 1024 + 512);
                const bf16x8 vf = (bf16x8){lo[0], lo[1], lo[2], lo[3], hh[0], hh[1], hh[2], hh[3]};
                o[d0] = __builtin_amdgcn_mfma_f32_32x32x16_bf16(pa[s], vf, o[d0], 0, 0, 0); }
    }
    lsum = hsum32(lsum);
    FA_WAIT_BAR(0);
    { const float inv = (c == 0 ? 1.0f : -lam) / lsum; if (hi == 0) wsf[r32] = inv; LDS_WAIT();
#pragma unroll
      for (int r = 0; r < 16; ++r) { const float fr = wsf[CR(r) + 4 * hi];
#pragma unroll
          for (int d0 = 0; d0 < 4; ++d0) o[d0][r] *= fr; } }
    LAS float* X = (LAS float*)(lds + L_X) + rg * 4096 + lane;
    if (c == 1) {
#pragma unroll
        for (int d0 = 0; d0 < 4; ++d0)
#pragma unroll
            for (int r = 0; r < 16; ++r) X[(d0 * 16 + r) * 64] = o[d0][r]; }
    FA_WAIT_BAR(0);
    if (c == 0) {
        float rs[16];
#pragma unroll
        for (int r = 0; r < 16; ++r) { float ss = 0.f;
#pragma unroll
            for (int d0 = 0; d0 < 4; ++d0) { o[d0][r] += X[(d0 * 16 + r) * 64]; ss += o[d0][r] * o[d0][r]; }
#pragma unroll
            for (int m = 1; m < 32; m <<= 1) ss += __shfl_xor(ss, m);
            rs[r] = __builtin_amdgcn_rsqf(ss * (1.0f / 128.0f) + EPS) * (1.0f - lam_init); }
        LAS bf16* stg = (LAS bf16*)(lds + L_OST + rg * 8192);
#pragma unroll
        for (int d0 = 0; d0 < 4; ++d0) { const float g = og[d0 * 32 + r32];
#pragma unroll
            for (int r = 0; r < 16; ++r) stg[(CR(r) + 4 * hi) * 128 + d0 * 32 + r32] = (bf16)f2bf(o[d0][r] * rs[r] * g); }
        LDS_WAIT();
        bf16* Ow = O + (rowb + qb * 128 + rg * 32) * DM + AW + h * 128;
#pragma unroll
        for (int k = 0; k < 8; ++k) { const int row = k * 4 + (lane >> 4), ch = lane & 15; const u32x4 v = *(const LAS u32x4*)(stg + row * 128 + ch * 8); *(GAS u32x4*)(Ow + (size_t)row * DM + ch * 8) = v; }
    }
    FA_WAIT_BAR(0);
#undef FA_DMA
}
__device__ __forceinline__ void attn_phase(Frame& F, const bf16* P, bf16* O, const float* lp, const float* og, int layer) {
    const float lam_init = 0.8f - 0.6f * __expf(-0.3f * (float)layer);
    float lam; { const int lane = threadIdx.x & 63; const float a = wave_sum(lp[lane] * lp[64 + lane]), cc = wave_sum(lp[128 + lane] * lp[192 + lane]); lam = __expf(a) - __expf(cc) + lam_init; }
    for (int v = F.vcu; v < 256; v += F.G) { const int bh = v >> 2, s = v & 3;
        for (int k = 0; k < 8; ++k) { const int qb = (k & 1) ? 31 - 4 * (k >> 1) - s : 4 * (k >> 1) + s;
            attn_unit(P, O, bh >> 4, bh & 15, qb, lam, lam_init, og, F.lds + RING_OFF); } }
}
#undef FA_WAIT_BAR
}
#ifndef SKIP_P0
#define SKIP_P0 0
#endif
#ifndef SKIP_G1
#define SKIP_G1 0
#endif
#ifndef SKIP_G2
#define SKIP_G2 0
#endif
#ifndef SKIP_G3
#define SKIP_G3 0
#endif
#ifndef SKIP_G4
#define SKIP_G4 0
#endif
#ifndef SKIP_HREF
#define SKIP_HREF 0
#endif
#ifndef SKIP_AREF
#define SKIP_AREF 0
#endif
#ifndef SKIP_MIX
#define SKIP_MIX 0
#endif
struct Args { const float* in[14]; float* out; unsigned char* ws; int ph_lo, ph_hi, li, pad; };
constexpr int PH_PER_LAYER = 6, N_PHASES = 1 + DEPTH * PH_PER_LAYER;

__device__ __forceinline__ void p0_prologue(Frame& F, const Args& args) {
    int tid_ = threadIdx.x; asm volatile("" : "+v"(tid_)); const int lane = tid_ & 63, wave = __builtin_amdgcn_readfirstlane(tid_ >> 6);
    LAS float* scr = (LAS float*)(F.lds + RING_OFF + wave * 16384);
    const int gw = F.vcu * NWAVES + wave, NGW = F.G * NWAVES;
    unsigned char* ws = args.ws;
    constexpr int I_IN = (DM / 64) * (INC / 32), I_OUT = (DM / 64) * (DM / 32), I_UP = (DM / 64) * (FF / 32), I_DN = (FF / 64) * (DM / 32);
    constexpr int I_LAYER = I_IN + I_OUT + I_UP + I_DN;
    for (int it = gw; it < DEPTH * I_LAYER; it += NGW) {
        const int l = it / I_LAYER; int r = it % I_LAYER;
        if (r < I_IN) { p0_transpose_item(args.in[3] + (size_t)l * DM * INC, DM, INC, (bf16*)(ws + WS_WIN) + (size_t)l * INC * DM, args.in[2] + l * DM, C_BQ, C_BV, scr, r, lane); continue; } r -= I_IN;
        if (r < I_OUT) { p0_transpose_item(args.in[10] + (size_t)l * DM * DM, DM, DM, (bf16*)(ws + WS_WOUT) + (size_t)l * DM * DM, nullptr, 0, 0, scr, r, lane); continue; } r -= I_OUT;
        if (r < I_UP) { p0_transpose_item(args.in[12] + (size_t)l * DM * FF, DM, FF, (bf16*)(ws + WS_WUP) + (size_t)l * FF * DM, args.in[11] + l * DM, 0, 0, scr, r, lane); continue; } r -= I_UP;
        p0_transpose_item(args.in[13] + (size_t)l * FF * DM, FF, DM, (bf16*)(ws + WS_WDN) + (size_t)l * DM * FF, nullptr, 0, 0, scr, r, lane);
    }
    bf16* HB = (bf16*)(ws + WS_HB); float* ssq0 = (float*)(ws + WS_SSQ);
    for (int m = gw; m < MROWS; m += NGW) row_to_bf16_ssq(m < MR ? args.in[0] + (size_t)m * DM : args.in[1] + (size_t)(m - MR) * DM, HB + (size_t)m * DM, ssq0 + m, lane);
}

__global__ void __launch_bounds__(NWAVES * 64, 2) fwd(Args args) {
    extern __shared__ __attribute__((aligned(16))) unsigned char lds[];
    Frame F;
    F.lds = (LAS unsigned char*)lds;
    F.MISC = (volatile LAS unsigned*)(F.lds + MISC_OFF);
    F.tid = threadIdx.x; F.lane = F.tid & 63; F.wave = __builtin_amdgcn_readfirstlane(F.tid >> 6);
    F.G = gridDim.x; { const int bx = blockIdx.x; F.vcu = (F.G % 8 == 0) ? (bx % 8) * (F.G / 8) + bx / 8 : bx; }
    unsigned char* ws = args.ws;
    F.ctl = (gu32*)(ws + WS_CTL);
    for (int u = F.tid; u < (LDS_BYTES - LDSCTL_OFF) / 4; u += NWAVES * 64) ((LAS unsigned*)(F.lds + LDSCTL_OFF))[u] = 0u;
    __syncthreads();
    XcdBarrier bar = xcd_barrier_post((unsigned*)(F.ctl + CW_BAR) + args.li * XCD_BAR_WORDS, F.MISC + 8);
    const int lo = args.ph_lo, hi = args.ph_hi;
#define IN(k) (lo <= (k) && (k) < hi)
#define SEAM(k) do { if (IN(k) && IN((k) + 1)) xcd_barrier(bar); } while (0)
    bf16* WIN = (bf16*)(ws + WS_WIN); bf16* WOUT = (bf16*)(ws + WS_WOUT); bf16* WUP = (bf16*)(ws + WS_WUP); bf16* WDN = (bf16*)(ws + WS_WDN);
    float* H = (float*)(ws + WS_H); bf16* HB = (bf16*)(ws + WS_HB); bf16* OB = (bf16*)(ws + WS_O); bf16* PZ = (bf16*)(ws + WS_PZ); float* OSCR = (float*)(ws + WS_OSCR);

    if (IN(0) && !SKIP_P0) { p0_prologue(F, args); } SEAM(0);

    for (int l = 0; l < DEPTH; ++l) {
        const int pb = 1 + l * PH_PER_LAYER;
        float* ssqA = (float*)(ws + WS_SSQ + (size_t)(2 * l) * SSQ_STRIDE); float* ssqB = (float*)(ws + WS_SSQ + (size_t)(2 * l + 1) * SSQ_STRIDE); float* ssqC = (float*)(ws + WS_SSQ + (size_t)(2 * l + 2) * SSQ_STRIDE);
        if (IN(pb + 0) && !SKIP_G1) {
            pg8::Gemm g{HB, WIN + (size_t)l * INC * DM, MP, INC, DM}; pg8::StaticOrder S; S.init(MP, INC, F.G, (int)blockIdx.x);
            pg8::EpiIn E{PZ, INC, ssqA, args.in[6] + l * 128, args.in[7] + l * 128, QSCALE};
            pg8::gemm_phase<pg8::EpiIn, pg8::StaticOrder, true, true>(F.lds + RING_OFF, g, S, E);
        }
        SEAM(pb + 0);
        if (IN(pb + 1) && !SKIP_MIX) {
#if !SKIP_HREF
            hgrn_ref_chain(F, PZ, OSCR, args.in[4], l);
#endif
            __syncthreads();
            fa::attn_phase(F, PZ, OB, args.in[8] + l * 256, args.in[9] + l * 128, l);
            __syncthreads();
#if !SKIP_AREF
            attn_ref(F, PZ, OB, args.in[8] + l * 256, args.in[9] + l * 128, l, MR * 16, MROWS * 16);
#endif
        }
        SEAM(pb + 1);
        if (IN(pb + 2) && !SKIP_MIX && !SKIP_HREF) { hgrn_ref_norm(F, PZ, OSCR, OB, args.in[5] + l * 128); }
        SEAM(pb + 2);
        if (IN(pb + 3) && !SKIP_G2) {
            pg8::Gemm g{OB, WOUT + (size_t)l * DM * DM, MP, DM, DM}; pg8::StaticOrder S; S.init(MP, DM, F.G, (int)blockIdx.x);
            pg8::EpiRes E{l == 0 ? args.in[0] : H, l == 0 ? args.in[1] : H + (size_t)MR * DM, H, HB, ssqB};
            pg8::gemm_phase<pg8::EpiRes, pg8::StaticOrder, true, true>(F.lds + RING_OFF, g, S, E);
        }
        SEAM(pb + 3);
        if (IN(pb + 4) && !SKIP_G3) {
            pg8::Gemm g{HB, WUP + (size_t)l * FF * DM, MP, FF, DM}; pg8::StaticOrder S; S.init(MP, FF, F.G, (int)blockIdx.x);
            pg8::EpiUp E{PZ, FF, ssqB};
            pg8::gemm_phase<pg8::EpiUp, pg8::StaticOrder, true, true>(F.lds + RING_OFF, g, S, E);
        }
        SEAM(pb + 4);
        if (IN(pb + 5) && !SKIP_G4) {
            const bool last = (l == DEPTH - 1); const int Mg = last ? MR : MP;
            pg8::Gemm g{PZ, WDN + (size_t)l * DM * FF, Mg, DM, FF}; pg8::StaticOrder S; S.init(Mg, DM, F.G, (int)blockIdx.x);
            pg8::EpiRes E{H, H + (size_t)MR * DM, last ? args.out : H, last ? nullptr : HB, last ? nullptr : ssqC};
            pg8::gemm_phase<pg8::EpiRes, pg8::StaticOrder, true, true>(F.lds + RING_OFF, g, S, E);
        }
        SEAM(pb + 5);
    }
#undef IN
#undef SEAM
}

#ifndef MK_CUTS
#define MK_CUTS 0
#endif
extern "C" void kernel_launch(void* const* d_in, const int* in_sizes, int n_in, void* d_out, int out_size, void* d_ws, size_t ws_size, hipStream_t stream) {
    static int grid = 0;
    if (grid == 0) {
        if (n_in != 14 || in_sizes[0] != MR * DM || out_size != MR * DM || ws_size < WS_END) { fprintf(stderr, "kernel_launch: unexpected shapes / workspace (%d inputs, ws %zu < %zu)\n", n_in, ws_size, (size_t)WS_END); grid = -1; return; }
        int dev = 0, cus = 0, per_cu = 0;
        if (hipGetDevice(&dev) != hipSuccess || hipDeviceGetAttribute(&cus, hipDeviceAttributeMultiprocessorCount, dev) != hipSuccess) { grid = -1; return; }
        if (hipFuncSetAttribute((const void*)fwd, hipFuncAttributeMaxDynamicSharedMemorySize, LDS_BYTES) != hipSuccess) { fprintf(stderr, "kernel_launch: hipFuncSetAttribute failed\n"); grid = -1; return; }
        if (hipOccupancyMaxActiveBlocksPerMultiprocessor(&per_cu, (const void*)fwd, NWAVES * 64, LDS_BYTES) != hipSuccess || per_cu < 1) { fprintf(stderr, "kernel_launch: occupancy query says %d\n", per_cu); }
        (void)hipGetLastError();
        grid = cus;
    }
    if (grid < 0) return;
    if (hipMemsetAsync((char*)d_ws + WS_CTL, 0, CTL_ZERO_BYTES, stream) != hipSuccess) return;
    Args a{};
    for (int i = 0; i < 14; ++i) a.in[i] = (const float*)d_in[i];
    a.out = (float*)d_out; a.ws = (unsigned char*)d_ws;
#if MK_CUTS == 0
    a.ph_lo = 0; a.ph_hi = N_PHASES; a.li = 0; a.pad = 0;
    hipLaunchKernelGGL(fwd, dim3(grid), dim3(NWAVES * 64), LDS_BYTES, stream, a);
#else
    for (int p = 0; p < N_PHASES; ++p) { a.ph_lo = p; a.ph_hi = p + 1; a.li = p; a.pad = 0; hipLaunchKernelGGL(fwd, dim3(grid), dim3(NWAVES * 64), LDS_BYTES, stream, a); }
#endif
}
```

```cpp
#include <hip/hip_runtime.h>
#include <cstdio>
#include <cstdint>
namespace pg8 {
#define PG8_LAS __attribute__((address_space(3)))
typedef unsigned short bf16_t;
typedef short bf16x8 __attribute__((ext_vector_type(8)));
typedef float f32x4 __attribute__((ext_vector_type(4)));
typedef unsigned u32x4 __attribute__((ext_vector_type(4)));
constexpr int BM = 256, BK = 64, HALF = 128, HTB = HALF * BK * 2  , STAGE_BYTES = 8 * HTB, NXCD = 8, WGM = 8;

__host__ __device__ __forceinline__ int lds_byte(int r, int c) { const int st = (r >> 4) * 2 + (c >> 5), rr = r & 15, cc = c & 31, ob = rr * 64 + cc * 2; return st * 1024 + (ob ^ (((ob >> 9) & 1) << 5)); }
__host__ __device__ __forceinline__ void stage_rc(int b, int& R, int& C) { const int st = b / 1024, sb = b % 1024, swz = sb ^ (((sb >> 9) & 1) << 5); R = (st >> 1) * 16 + swz / 64; C = (st & 1) * 32 + (swz % 64) / 2; }
__host__ __device__ __forceinline__ int perm32(int rho) { const int n = rho >> 4, i = rho & 15; return 8 * (i >> 2) + 4 * n + (i & 3); }

struct Unit { int pm, pn; };
struct Gemm { const bf16_t* A; const bf16_t* Bt; int M, N, K; };

struct StaticOrder {
    int nM, nN, nwg, G, c, wgm;
    __host__ __device__ void init(int M, int N, int G_, int c_, int wgm_ = WGM) { nM = M / BM; nN = N / BM; nwg = nM * nN; G = G_; c = c_; wgm = wgm_; }
    __host__ __device__ bool next(int i, Unit& u) const {
        const long L = (long)i * G + c; if (L >= nwg) return false;
        int wgid = (int)L; { const int q = nwg / NXCD, r = nwg % NXCD, xcd = wgid % NXCD, off = wgid / NXCD; wgid = (xcd < r ? xcd * (q + 1) : r * (q + 1) + (xcd - r) * q) + off; }
        const int nig = wgm * nN, gid = wgid / nig, fm = gid * wgm, gsz = (nM - fm) < wgm ? (nM - fm) : wgm;
        u.pm = fm + ((wgid % nig) % gsz); u.pn = (wgid % nig) / gsz; return true;
    }
    __device__ __forceinline__ void a_ready(const Unit&) const {}
    __device__ __forceinline__ void done(const Unit&) const {}
};

__device__ __forceinline__ unsigned cvt_pk_bf16(float lo, float hi) { unsigned r; asm volatile("v_cvt_pk_bf16_f32 %0, %1, %2" : "=v"(r) : "v"(lo), "v"(hi)); return r; }
typedef float f32x2 __attribute__((ext_vector_type(2)));
constexpr int E_D = 4096, E_MR = 16384, E_MROWS = 16400;
constexpr float E_EPS = 1e-6f;
__device__ __forceinline__ u32x4 pack8(const f32x4 a, const f32x4 b) { u32x4 w; w.x = cvt_pk_bf16(a[0], a[1]); w.y = cvt_pk_bf16(a[2], a[3]); w.z = cvt_pk_bf16(b[0], b[1]); w.w = cvt_pk_bf16(b[2], b[3]); return w; }
struct EpiIn {
    static constexpr bool PERM = true, AFTER_DRAIN = false;
    bf16_t* P; int ldp; const float* ssq; const float* gq; const float* gk; float qscale; const float* lb;
    __device__ __forceinline__ void pre(const Unit& u, int wr, int fr, float (&aux)[8]) const {
#pragma unroll
        for (int k = 0; k < 8; ++k) aux[k] = ssq[u.pm * BM + wr * 64 + fr + (k >> 2) * HALF + (k & 3) * 16]; }
    __device__ __forceinline__ void operator()(const f32x4 (&acc)[2][2][4][2], const Unit& u, int wr, int wc, int fr, int fq, const float (&aux)[8]) const {
        const int row0 = u.pm * BM + wr * 64 + fr;
        const int sect = u.pn >> 3;
        if (sect == 4 || sect == 5) {
            const float* g = (sect == 4 ? gq : gk) + (wc & 1) * 64; const float sc = sect == 4 ? qscale : 1.f;
            f32x4 gv[2][2];
#pragma unroll
            for (int bj = 0; bj < 2; ++bj)
#pragma unroll
                for (int n = 0; n < 2; ++n) gv[bj][n] = *(const f32x4*)(g + 32 * bj + 8 * fq + 4 * n) * sc;
#pragma unroll
            for (int ai = 0; ai < 2; ++ai)
#pragma unroll
                for (int m = 0; m < 4; ++m) { const int row = row0 + ai * HALF + m * 16;
                    const float rs = __builtin_amdgcn_rsqf(aux[ai * 4 + m] * (1.0f / E_D) + E_EPS);
                    f32x4 v[2][2]; float ss = 0.f;
#pragma unroll
                    for (int bj = 0; bj < 2; ++bj)
#pragma unroll
                        for (int n = 0; n < 2; ++n) { v[bj][n] = acc[ai][bj][m][n] * rs; const f32x4 q = v[bj][n] * v[bj][n]; ss += (q[0] + q[1]) + (q[2] + q[3]); }
                    ss += __shfl_xor(ss, 16); ss += __shfl_xor(ss, 32);
                    const float r2 = __builtin_amdgcn_rsqf(ss * (1.0f / 64.0f) + E_EPS);
                    bf16_t* rowp = P + (size_t)row * ldp + u.pn * BM + 64 * wc + 8 * fq;
#pragma unroll
                    for (int bj = 0; bj < 2; ++bj) *(u32x4*)(rowp + 32 * bj) = pack8(v[bj][0] * r2 * gv[bj][0], v[bj][1] * r2 * gv[bj][1]); }
        } else if (sect == 1) {
            f32x4 lbv[2][2];
#pragma unroll
            for (int bj = 0; bj < 2; ++bj)
#pragma unroll
                for (int n = 0; n < 2; ++n) lbv[bj][n] = *(const f32x4*)(lb + (u.pn - 8) * BM + 64 * wc + 32 * bj + 8 * fq + 4 * n);
#pragma unroll
            for (int ai = 0; ai < 2; ++ai)
#pragma unroll
                for (int m = 0; m < 4; ++m) { const int row = row0 + ai * HALF + m * 16;
                    const float rs = __builtin_amdgcn_rsqf(aux[ai * 4 + m] * (1.0f / E_D) + E_EPS);
                    bf16_t* rowp = P + (size_t)row * ldp + u.pn * BM + 64 * wc + 8 * fq;
#pragma unroll
                    for (int bj = 0; bj < 2; ++bj) { f32x4 o[2];
#pragma unroll
                        for (int n = 0; n < 2; ++n)
#pragma unroll
                            for (int i = 0; i < 4; ++i) { const float x = acc[ai][bj][m][n][i] * rs, sg = __builtin_amdgcn_rcpf(1.0f + __expf(-x)), l0 = lbv[bj][n][i]; o[n][i] = fmaxf(__logf(l0 + (1.0f - l0) * sg), -60.0f); }
                        *(u32x4*)(rowp + 32 * bj) = pack8(o[0], o[1]); } }
        } else {
#pragma unroll
            for (int ai = 0; ai < 2; ++ai)
#pragma unroll
                for (int m = 0; m < 4; ++m) { const int row = row0 + ai * HALF + m * 16;
                    const float rs = __builtin_amdgcn_rsqf(aux[ai * 4 + m] * (1.0f / E_D) + E_EPS);
                    bf16_t* rowp = P + (size_t)row * ldp + u.pn * BM + 64 * wc + 8 * fq;
#pragma unroll
                    for (int bj = 0; bj < 2; ++bj) *(u32x4*)(rowp + 32 * bj) = pack8(acc[ai][bj][m][0] * rs, acc[ai][bj][m][1] * rs); }
        }
    }
};
struct EpiUp {
    static constexpr bool PERM = true, AFTER_DRAIN = false;
    bf16_t* Z; int ldz; const float* ssq;
    __device__ __forceinline__ void pre(const Unit& u, int wr, int fr, float (&aux)[8]) const {
#pragma unroll
        for (int k = 0; k < 8; ++k) aux[k] = ssq[u.pm * BM + wr * 64 + fr + (k >> 2) * HALF + (k & 3) * 16]; }
    __device__ __forceinline__ void operator()(const f32x4 (&acc)[2][2][4][2], const Unit& u, int wr, int wc, int fr, int fq, const float (&aux)[8]) const {
        const int row0 = u.pm * BM + wr * 64 + fr;
#pragma unroll
        for (int ai = 0; ai < 2; ++ai)
#pragma unroll
            for (int m = 0; m < 4; ++m) { const int row = row0 + ai * HALF + m * 16;
                const float rs = __builtin_amdgcn_rsqf(aux[ai * 4 + m] * (1.0f / E_D) + E_EPS);
                bf16_t* rowp = Z + (size_t)row * ldz + u.pn * BM + 64 * wc + 8 * fq;
#pragma unroll
                for (int bj = 0; bj < 2; ++bj) { f32x4 a = acc[ai][bj][m][0] * rs, b = acc[ai][bj][m][1] * rs;
                    a = __builtin_elementwise_max(a, (f32x4){0.f, 0.f, 0.f, 0.f}); b = __builtin_elementwise_max(b, (f32x4){0.f, 0.f, 0.f, 0.f});
                    *(u32x4*)(rowp + 32 * bj) = pack8(a * a, b * b); } }
    }
};
struct EpiRes {
    static constexpr bool PERM = true, AFTER_DRAIN = false;
    const float* basef; bf16_t* hb; float* outf; float* ssq;
    __device__ __forceinline__ void pre(const Unit&, int, int, float (&)[8]) const {}
    __device__ __forceinline__ void operator()(const f32x4 (&acc)[2][2][4][2], const Unit& u, int wr, int wc, int fr, int fq, const float (&)[8]) const {
        const int row0 = u.pm * BM + wr * 64 + fr; const int col0 = u.pn * BM + 64 * wc + 8 * fq;
#pragma unroll
        for (int ai = 0; ai < 2; ++ai)
#pragma unroll
            for (int m = 0; m < 4; ++m) { const size_t off = (size_t)(row0 + ai * HALF + m * 16) * E_D + col0;
                float part = 0.f;
#pragma unroll
                for (int bj = 0; bj < 2; ++bj) { f32x4 a, b;
                    if (basef) { a = *(const f32x4*)(basef + off + 32 * bj); b = *(const f32x4*)(basef + off + 32 * bj + 4); }
                    else { const u32x4 r = *(const u32x4*)(hb + off + 32 * bj);
                        a = (f32x4){__uint_as_float(r.x << 16), __uint_as_float(r.x & 0xffff0000u), __uint_as_float(r.y << 16), __uint_as_float(r.y & 0xffff0000u)};
                        b = (f32x4){__uint_as_float(r.z << 16), __uint_as_float(r.z & 0xffff0000u), __uint_as_float(r.w << 16), __uint_as_float(r.w & 0xffff0000u)}; }
                    a += acc[ai][bj][m][0]; b += acc[ai][bj][m][1];
                    if (outf) { *(f32x4*)(outf + off + 32 * bj) = a; *(f32x4*)(outf + off + 32 * bj + 4) = b; }
                    else { *(u32x4*)(hb + off + 32 * bj) = pack8(a, b);
                        const f32x4 qa = a * a, qb = b * b; part += ((qa[0] + qa[1]) + (qa[2] + qa[3])) + ((qb[0] + qb[1]) + (qb[2] + qb[3])); } }
                if (!outf) { part += __shfl_xor(part, 16); part += __shfl_xor(part, 32); if (fq == 0) atomicAdd(ssq + row0 + ai * HALF + m * 16, part); }
                if (m == 3) asm volatile("" ::: "memory"); }
    }
};
template <class Epi, class Sched, bool ALIGN_EPI = false, bool SP2 = false>
__device__ __forceinline__ void gemm_phase(PG8_LAS unsigned char* lds, const Gemm g, const Sched& S, const Epi& E) {
    int tid_ = threadIdx.x; asm volatile("" : "+v"(tid_));
    const int tid = tid_, wid = __builtin_amdgcn_readfirstlane(tid >> 6), lane = tid & 63, wr = wid >> 2, wc = wid & 3, fr = lane & 15, fq = lane >> 4;
    const int K = g.K, nt = K / BK;
    unsigned voffA[2], voffB[2];
#pragma unroll
    for (int i = 0; i < 2; ++i) { int R, C; stage_rc(tid * 16 + i * 8192, R, C); const int Rb = Epi::PERM ? ((R & ~31) + perm32(R & 31)) : R;
        voffA[i] = (unsigned)(R * K + C) * 2u; voffB[i] = (unsigned)(Rb * K + C) * 2u; }
    const size_t kstep = (size_t)(BK * 2);
    const size_t hstep = (size_t)HALF * K * 2;
    const size_t tstep = 2 * hstep;
    const unsigned ldsw = (unsigned)wid * 1024u;
    const int aoff = lds_byte(wr * 64 + fr, fq * 8), boff = lds_byte(wc * 32 + fr, fq * 8);
#define PG8_SA(b, h) (((b) * 2 + (h)) * HTB)
#define PG8_SB(b, h) ((4 + (b) * 2 + (h)) * HTB)
#define PG8_STAGE(bufoff, gbase, voff) do { _Pragma("unroll") for (int _i = 0; _i < 2; ++_i) \
        __builtin_amdgcn_global_load_lds((const unsigned*)((const char*)(gbase) + (voff)[_i]), (PG8_LAS unsigned*)(lds + (bufoff) + ldsw + _i * 8192), 16, 0, 0); } while (0)
#define PG8_LDA(dst, b, h) do { _Pragma("unroll") for (int m = 0; m < 4; ++m) _Pragma("unroll") for (int k = 0; k < 2; ++k) dst[m][k] = *(const PG8_LAS bf16x8*)(lds + PG8_SA(b, h) + aoff + m * 2048 + k * 1024); } while (0)
#define PG8_LDB(dst, b, h) do { _Pragma("unroll") for (int n = 0; n < 2; ++n) _Pragma("unroll") for (int k = 0; k < 2; ++k) dst[n][k] = *(const PG8_LAS bf16x8*)(lds + PG8_SB(b, h) + boff + n * 2048 + k * 1024); } while (0)
#define PG8_MMA(ai, bj, At, Bt) do { __builtin_amdgcn_s_setprio(1); _Pragma("unroll") for (int m = 0; m < 4; ++m) _Pragma("unroll") for (int n = 0; n < 2; ++n) _Pragma("unroll") for (int k = 0; k < 2; ++k) \
        acc[ai][bj][m][n] = __builtin_amdgcn_mfma_f32_16x16x32_bf16(Bt[n][k], At[m][k], acc[ai][bj][m][n], 0, 0, 0); __builtin_amdgcn_s_setprio(0); } while (0)
#define PG8_WAIT_V(n) asm volatile("s_waitcnt vmcnt(" #n ")" ::: "memory")
#define PG8_WAIT_L(n) asm volatile("s_waitcnt lgkmcnt(" #n ")" ::: "memory")
#define PG8_BAR __builtin_amdgcn_s_barrier()
#define PG8_SCHED __builtin_amdgcn_sched_barrier(0)
    Unit cur, nxt; int ui = 0;
    if (!S.next(0, cur)) return;
    f32x4 acc[2][2][4][2];
#pragma unroll
    for (int a = 0; a < 2; ++a)
#pragma unroll
        for (int b = 0; b < 2; ++b)
#pragma unroll
            for (int m = 0; m < 4; ++m)
#pragma unroll
                for (int n = 0; n < 2; ++n) acc[a][b][m][n] = (f32x4){0.f, 0.f, 0.f, 0.f};
    bf16x8 At[4][2], B0[2][2], B1[2][2];
    const char* cA = (const char*)g.A + (size_t)cur.pm * tstep; const char* cB = (const char*)g.Bt + (size_t)cur.pn * tstep;
    float eaux[8]; E.pre(cur, wr, fr, eaux);
    S.a_ready(cur);
    if constexpr (SP2) {
        PG8_STAGE(PG8_SB(0, 0), cB, voffB); PG8_STAGE(PG8_SB(0, 1), cB + hstep, voffB); PG8_STAGE(PG8_SA(0, 0), cA, voffA); PG8_STAGE(PG8_SA(0, 1), cA + hstep, voffA);
        if (wr == 1) PG8_BAR;
        PG8_WAIT_V(2); PG8_BAR;
        PG8_STAGE(PG8_SB(1, 0), cB + kstep, voffB); PG8_STAGE(PG8_SA(1, 0), cA + kstep, voffA); PG8_STAGE(PG8_SB(1, 1), cB + hstep + kstep, voffB);
        PG8_WAIT_V(6); PG8_BAR;
    } else {
        PG8_STAGE(PG8_SB(0, 0), cB, voffB); PG8_STAGE(PG8_SA(0, 0), cA, voffA); PG8_STAGE(PG8_SB(0, 1), cB + hstep, voffB); PG8_STAGE(PG8_SA(0, 1), cA + hstep, voffA);
        if (wr == 1) PG8_BAR;
        PG8_WAIT_V(4); PG8_BAR;
        PG8_STAGE(PG8_SB(1, 0), cB + kstep, voffB); PG8_STAGE(PG8_SA(1, 0), cA + kstep, voffA); PG8_STAGE(PG8_SB(1, 1), cB + hstep + kstep, voffB);
        PG8_WAIT_V(6); PG8_BAR;
    }
    for (;;) {
        const bool has_next = S.next(ui + 1, nxt);
        const char* nA = has_next ? (const char*)g.A + (size_t)nxt.pm * tstep : cA; const char* nB = has_next ? (const char*)g.Bt + (size_t)nxt.pn * tstep : cB;
        for (int t = 0; t < nt; t += 2) {
            const bool last = (t == nt - 2);
            const char* a1 = cA + (size_t)(t + 1) * kstep;
            const char* a2 = last ? nA : cA + (size_t)(t + 2) * kstep; const char* b2 = last ? nB : cB + (size_t)(t + 2) * kstep;
            const char* a3 = a2 + kstep; const char* b3 = b2 + kstep;
            if (last && has_next) S.a_ready(nxt);
            if constexpr (SP2) {
            PG8_LDB(B0, 0, 0); PG8_LDB(B1, 0, 1); PG8_SCHED; PG8_LDA(At, 0, 0); PG8_STAGE(PG8_SA(1, 1), a1 + hstep, voffA);
            PG8_WAIT_V(8); PG8_WAIT_L(0); PG8_BAR; PG8_MMA(0, 0, At, B0); PG8_MMA(0, 1, At, B1); PG8_BAR; PG8_SCHED;
            PG8_LDA(At, 0, 1); PG8_STAGE(PG8_SB(0, 0), b2, voffB); PG8_STAGE(PG8_SB(0, 1), b2 + hstep, voffB); PG8_STAGE(PG8_SA(0, 0), a2, voffA);
            PG8_WAIT_V(8); PG8_WAIT_L(0); PG8_BAR; PG8_MMA(1, 0, At, B0); PG8_MMA(1, 1, At, B1); PG8_BAR; PG8_SCHED;
            PG8_LDB(B0, 1, 0); PG8_LDB(B1, 1, 1); PG8_SCHED; PG8_LDA(At, 1, 0); PG8_STAGE(PG8_SA(0, 1), a2 + hstep, voffA);
            PG8_WAIT_V(8); PG8_WAIT_L(0); PG8_BAR; PG8_MMA(0, 0, At, B0); PG8_MMA(0, 1, At, B1); PG8_BAR; PG8_SCHED;
            PG8_LDA(At, 1, 1); PG8_STAGE(PG8_SB(1, 0), b3, voffB); PG8_STAGE(PG8_SB(1, 1), b3 + hstep, voffB); PG8_STAGE(PG8_SA(1, 0), a3, voffA);
            PG8_WAIT_V(8); PG8_WAIT_L(0); PG8_BAR; PG8_MMA(1, 0, At, B0); PG8_MMA(1, 1, At, B1); PG8_BAR; PG8_SCHED;
            } else {
            PG8_LDB(B0, 0, 0); PG8_SCHED; PG8_LDA(At, 0, 0); PG8_STAGE(PG8_SA(1, 1), a1 + hstep, voffA);
            PG8_WAIT_L(8); PG8_BAR; PG8_WAIT_L(0); PG8_MMA(0, 0, At, B0); PG8_BAR; PG8_SCHED;
            PG8_LDB(B1, 0, 1); PG8_STAGE(PG8_SB(0, 0), b2, voffB);
            PG8_BAR; PG8_WAIT_L(0); PG8_MMA(0, 1, At, B1); PG8_BAR;
            PG8_LDA(At, 0, 1); PG8_STAGE(PG8_SA(0, 0), a2, voffA);
            PG8_BAR; PG8_WAIT_L(0); PG8_MMA(1, 0, At, B0); PG8_BAR; PG8_SCHED;
            PG8_STAGE(PG8_SB(0, 1), b2 + hstep, voffB);
            PG8_WAIT_V(6); PG8_BAR; PG8_MMA(1, 1, At, B1); PG8_BAR;
            PG8_LDB(B0, 1, 0); PG8_SCHED; PG8_LDA(At, 1, 0); PG8_STAGE(PG8_SA(0, 1), a2 + hstep, voffA);
            PG8_WAIT_L(8); PG8_BAR; PG8_WAIT_L(0); PG8_MMA(0, 0, At, B0); PG8_BAR; PG8_SCHED;
            PG8_LDB(B1, 1, 1); PG8_STAGE(PG8_SB(1, 0), b3, voffB);
            PG8_BAR; PG8_WAIT_L(0); PG8_MMA(0, 1, At, B1); PG8_BAR;
            PG8_LDA(At, 1, 1); PG8_STAGE(PG8_SA(1, 0), a3, voffA);
            PG8_BAR; PG8_WAIT_L(0); PG8_MMA(1, 0, At, B0); PG8_BAR; PG8_SCHED;
            PG8_STAGE(PG8_SB(1, 1), b3 + hstep, voffB);
            PG8_WAIT_V(6); PG8_BAR; PG8_MMA(1, 1, At, B1); PG8_BAR;
            }
        }
        if constexpr (ALIGN_EPI) { if (wr == 0) PG8_BAR; }
        if constexpr (!Epi::AFTER_DRAIN) { E(acc, cur, wr, wc, fr, fq, eaux); S.done(cur); if (has_next) E.pre(nxt, wr, fr, eaux); }
        if (!has_next) break;
#pragma unroll
        for (int a = 0; a < 2; ++a)
#pragma unroll
            for (int b = 0; b < 2; ++b)
#pragma unroll
                for (int m = 0; m < 4; ++m)
#pragma unroll
                    for (int n = 0; n < 2; ++n) acc[a][b][m][n] = (f32x4){0.f, 0.f, 0.f, 0.f};
        cur = nxt; cA = nA; cB = nB; ++ui;
        if constexpr (ALIGN_EPI) { if (wr == 1) PG8_BAR; }
    }
    PG8_WAIT_V(0);
    if constexpr (!ALIGN_EPI) { if (wr == 0) PG8_BAR; }
    PG8_BAR;
    if constexpr (Epi::AFTER_DRAIN) { E.fused(acc, cur, wr, wc, fr, fq, lds, wid, lane); S.done(cur); }
#undef PG8_SA
#undef PG8_SB
#undef PG8_STAGE
#undef PG8_LDA
#undef PG8_LDB
#undef PG8_MMA
#undef PG8_WAIT_V
#undef PG8_WAIT_L
#undef PG8_BAR
#undef PG8_SCHED
}
}
constexpr int NWAVES = 8;
constexpr int DM = 4096, SEQ = 4096, BATCH = 4, NMETA = 16, DEPTH = 2;
constexpr int MR = BATCH * SEQ;
constexpr int MROWS = MR + NMETA;
constexpr int MP = 65 * 256;
constexpr int INC = 14336, FF = 16384, AW = 2048;
constexpr int C_AQ = 0, C_AF = 2048, C_AI = 4096, C_AG = 6144, C_BQ = 8192, C_BK = 10240, C_BV = 12288;
constexpr float EPS = 1e-6f;
constexpr float LOG2E = 1.4426950408889634f;
constexpr float QSCALE = 0.125f * LOG2E;

constexpr size_t MiB = 1u << 20;
constexpr size_t WS_CTL = 0, CTL_ZERO_BYTES = 2 * MiB;
constexpr size_t WS_SSQ = 1 * MiB, SSQ_STRIDE = 128 * 1024;
constexpr size_t WS_LB = WS_SSQ + 5 * SSQ_STRIDE;
constexpr size_t WS_WIN = 4 * MiB;
constexpr size_t WS_WOUT = WS_WIN + (size_t)2 * INC * DM * 2;
constexpr size_t WS_WUP = WS_WOUT + (size_t)2 * DM * DM * 2;
constexpr size_t WS_WDN = WS_WUP + (size_t)2 * FF * DM * 2;
constexpr size_t WS_HB = WS_WDN + (size_t)2 * FF * DM * 2;
constexpr size_t WS_O = WS_HB + (size_t)MP * DM * 2;
constexpr size_t WS_PZ = WS_O + (size_t)MP * DM * 2;
constexpr size_t WS_END = WS_PZ + (size_t)MP * FF * 2;
static_assert(WS_END <= (size_t)2048 * MiB, "d_ws map");
constexpr int CW_TMO = 0, CW_CODE = 1;
constexpr int CW_BAR = 4096;
constexpr int MAX_LAUNCH = 16;
constexpr int CW_Q = 61440;

constexpr int RING_OFF = 0, RING_BYTES = 131072;
constexpr int LDS_BYTES = 163840;
constexpr int LDSCTL_OFF = LDS_BYTES - 1024, MISC_OFF = LDSCTL_OFF + 320;
#define GAS __attribute__((address_space(1)))
#define LAS __attribute__((address_space(3)))
typedef unsigned short bf16;
typedef unsigned v4u __attribute__((ext_vector_type(4)));
typedef float f32x4 __attribute__((ext_vector_type(4)));
typedef short bf16x8 __attribute__((ext_vector_type(8)));
typedef GAS unsigned gu32;
typedef GAS unsigned long long gu64;
#define RLX_AGENT __ATOMIC_RELAXED, __HIP_MEMORY_SCOPE_AGENT
#define LDS_WAIT() asm volatile("s_waitcnt lgkmcnt(0)" ::: "memory")
#define VM_WAIT() asm volatile("s_waitcnt vmcnt(0)" ::: "memory")
__device__ __forceinline__ unsigned long long rt() { return __builtin_amdgcn_s_memrealtime(); }
typedef float f32x2v_ __attribute__((ext_vector_type(2))); typedef __bf16 bf16x2v_ __attribute__((ext_vector_type(2)));
__device__ __forceinline__ unsigned pk2(float lo, float hi) { f32x2v_ v = {lo, hi}; bf16x2v_ r = __builtin_convertvector(v, bf16x2v_); return __builtin_bit_cast(unsigned, r); }
__device__ __forceinline__ unsigned f2bf(float f) { return pk2(f, 0.f) & 0xffffu; }

#define XB_TMO      128
#define XB_XCNT(j)  (256  + 64 * (j))
#define XB_XSUB(j)  (1280 + 64 * (j))
#define XB_XGEN(j)  (2304 + 64 * (j))
#define XB_TOP      3328
#define XB_TOPGEN   3392
#define XCD_BAR_WORDS 3456
#define XB_SPIN_CAP (1u << 18)

__device__ __forceinline__ unsigned xb_ld(unsigned* p)              { return __hip_atomic_load(p, __ATOMIC_RELAXED, __HIP_MEMORY_SCOPE_AGENT); }
__device__ __forceinline__ unsigned xb_add(unsigned* p, unsigned v) { return __hip_atomic_fetch_add(p, v, __ATOMIC_RELAXED, __HIP_MEMORY_SCOPE_AGENT); }
__device__ __forceinline__ unsigned xb_xcc_id() { return (unsigned)__builtin_amdgcn_s_getreg((3 << 11) | 20) & 0xFu; }
#define XB_SPIN(cond, bar) do { unsigned _sp = 0; while (cond) { __builtin_amdgcn_s_sleep(1); \
    if ((++_sp & 255u) == 0u) { if (xb_ld(&(bar)[XB_TMO])) break; if (_sp > XB_SPIN_CAP) { atomicAdd(&(bar)[XB_TMO], 1u); break; } } } } while (0)

struct XcdBarrier {
    unsigned* bar; unsigned x;
    volatile LAS unsigned* st;
};

__device__ __forceinline__ XcdBarrier xcd_barrier_post(unsigned* bar, volatile LAS unsigned* st) {
    XcdBarrier b; b.bar = bar; b.x = xb_xcc_id(); b.st = st;
    if (threadIdx.x == 0) (void)xb_add(&bar[XB_XCNT(b.x)], 1u);
    return b;
}
__device__ __forceinline__ void xcd_barrier_complete(unsigned* bar, unsigned x, unsigned& nloc, unsigned& nx) {
    const unsigned G = gridDim.x * gridDim.y * gridDim.z;
    unsigned sum, cnt, mine, sp = 0u;
    for (;;) {
        sum = 0u; cnt = 0u; mine = 0u;
#pragma unroll
        for (unsigned j = 0; j < 16; ++j) { const unsigned c = xb_ld(&bar[XB_XCNT(j)]); sum += c; cnt += (c > 0u) ? 1u : 0u; mine = (j == x) ? c : mine; }
        if (sum == G) break;
        __builtin_amdgcn_s_sleep(1);
        if ((++sp & 255u) == 0u) { if (xb_ld(&bar[XB_TMO])) break; if (sp > XB_SPIN_CAP) { atomicAdd(&bar[XB_TMO], 1u); break; } }
    }
    nloc = mine > 0u ? mine : 1u; nx = cnt > 0u ? cnt : 1u;
}

__device__ __forceinline__ void xcd_barrier(const XcdBarrier& b) {
    asm volatile("s_waitcnt vmcnt(0)" ::: "memory");
    __syncthreads();
    if (threadIdx.x == 0) {
        unsigned* bar = b.bar;
        __builtin_amdgcn_s_waitcnt(0);
        unsigned nloc = b.st[0], nx = b.st[1];
        if (nloc == 0u) { xcd_barrier_complete(bar, b.x, nloc, nx); b.st[0] = nloc; b.st[1] = nx; }
        const unsigned old = xb_add(&bar[XB_XSUB(b.x)], 1u);
        const unsigned gen = old / nloc;
        if (old + 1u == (gen + 1u) * nloc) {
            __builtin_amdgcn_fence(__ATOMIC_RELEASE, "agent");
            asm volatile("s_waitcnt vmcnt(0)" ::: "memory");
            const unsigned og = xb_add(&bar[XB_TOP], 1u);
            const unsigned tg = og / nx;
            if (og + 1u == (tg + 1u) * nx) xb_add(&bar[XB_TOPGEN], 1u);
            else XB_SPIN(xb_ld(&bar[XB_TOPGEN]) == tg, bar);
            __builtin_amdgcn_fence(__ATOMIC_ACQUIRE, "agent");
            xb_add(&bar[XB_XGEN(b.x)], 1u);
            asm volatile("s_waitcnt vmcnt(0)" ::: "memory");
        } else {
            XB_SPIN(xb_ld(&bar[XB_XGEN(b.x)]) == gen, bar);
            __builtin_amdgcn_fence(__ATOMIC_ACQUIRE, "agent");
            asm volatile("s_waitcnt vmcnt(0)" ::: "memory");
        }
    }
    __syncthreads();
}
static_assert(CW_BAR + MAX_LAUNCH * XCD_BAR_WORDS <= CW_Q && (CW_Q + (2 * DEPTH * 2 + DEPTH) * 512) * 4 <= (int)WS_SSQ, "CTL words");
struct Frame {
    LAS unsigned char* lds;
    volatile LAS unsigned* MISC;
    gu32* ctl;
    int tid, lane, wave;
    int vcu, G;
};
__device__ __forceinline__ float wave_sum(float v) {
#pragma unroll
    for (int o = 1; o < 64; o <<= 1) v += __shfl_xor(v, o);
    return v;
}
__device__ __forceinline__ float wave_max(float v) {
#pragma unroll
    for (int o = 1; o < 64; o <<= 1) v = fmaxf(v, __shfl_xor(v, o));
    return v;
}
typedef float f32x2 __attribute__((ext_vector_type(2)));
__device__ __forceinline__ float bf2f(unsigned short b) { return __uint_as_float((unsigned)b << 16); }
__device__ __forceinline__ float sigmoidf_(float x) { return 1.0f / (1.0f + __expf(-x)); }

constexpr int CV_LDS_WAVE = 64 * 144;
__device__ __forceinline__ int cv_perm(int n, int perm_lo, int perm_hi) {
    if (n >= perm_lo && n < perm_hi) { const int blk = (n & 255) >> 5, wc = blk >> 1, bj = blk & 1; return (n & ~255) + 32 * (4 * bj + wc) + (n & 31); }
    return n; }
__device__ __forceinline__ void p0_convert_unit(const float* W, int K, int N, bf16* WT, const float* g, int perm_lo, int perm_hi, int unit, int lane, LAS unsigned char* tile) {
    const int nb = N / 64, nblk = unit % nb, kseg = unit / nb, n = nblk * 64 + lane, k0 = kseg * 512;
    const GAS float* __restrict__ src = (const GAS float*)W + (size_t)k0 * N + n;
    float va[32], vb[32];
#define CV_LOAD(v_, h_) do { _Pragma("unroll") for (int j = 0; j < 32; ++j) v_[j] = __builtin_nontemporal_load(src + (size_t)((h_) * 32 + j) * N); } while (0)
#define CV_PACK(p_, v_, h_) do { if (g) { _Pragma("unroll") for (int j = 0; j < 32; ++j) v_[j] *= g[k0 + (h_) * 32 + j]; } \
        _Pragma("unroll") for (int q = 0; q < 4; ++q) p_[q] = (v4u){pk2(v_[8 * q], v_[8 * q + 1]), pk2(v_[8 * q + 2], v_[8 * q + 3]), pk2(v_[8 * q + 4], v_[8 * q + 5]), pk2(v_[8 * q + 6], v_[8 * q + 7])}; } while (0)
    CV_LOAD(va, 0); CV_LOAD(vb, 1);
    for (int c = 0; c < 8; ++c) {
        v4u pa[4], pb[4];
        CV_PACK(pa, va, 2 * c);     if (c < 7) CV_LOAD(va, 2 * c + 2);
        CV_PACK(pb, vb, 2 * c + 1); if (c < 7) CV_LOAD(vb, 2 * c + 3);
#pragma unroll
        for (int q = 0; q < 4; ++q) { *(LAS v4u*)(tile + lane * 144 + q * 16) = pa[q]; *(LAS v4u*)(tile + lane * 144 + 64 + q * 16) = pb[q]; }
        LDS_WAIT(); asm volatile("" ::: "memory");
#pragma unroll
        for (int r8 = 0; r8 < 8; ++r8) { const int row = r8 * 8 + (lane >> 3); const v4u x = *(const LAS v4u*)(tile + row * 144 + (lane & 7) * 16);
            *(GAS v4u*)(WT + (size_t)cv_perm(nblk * 64 + row, perm_lo, perm_hi) * K + k0 + c * 64 + (lane & 7) * 8) = x; }
        LDS_WAIT(); asm volatile("" ::: "memory");
    }
#undef CV_LOAD
#undef CV_PACK
}
__device__ __forceinline__ void row_to_bf16_ssq(const float* xrow, bf16* orow, float* ssq, int lane) {
    const GAS f32x4* xr = (const GAS f32x4*)xrow + lane;
    GAS unsigned long long* o8 = (GAS unsigned long long*)orow + lane;
    float s = 0.f;
#pragma unroll
    for (int j = 0; j < 16; ++j) { const f32x4 v = xr[64 * j]; s += (v.x * v.x + v.y * v.y) + (v.z * v.z + v.w * v.w);
        o8[64 * j] = (unsigned long long)pk2(v.x, v.y) | ((unsigned long long)pk2(v.z, v.w) << 32); }
    s = wave_sum(s);
    if (lane == 0) *ssq = s;
}
__device__ __forceinline__ void attn_ref(Frame& F, const bf16* P, bf16* O, const float* lp, const float* og, int layer, int u_lo, int u_hi) {
    LAS float* qf = (LAS float*)(F.lds + RING_OFF); LAS float* sc = qf + 128; LAS float* red = sc + 2 * 4112; LAS float* pvr = red + 64;
    int tid_ = threadIdx.x; asm volatile("" : "+v"(tid_)); const int tid = tid_, lane = tid & 63, wave = __builtin_amdgcn_readfirstlane(tid >> 6);
    const float lam_init = 0.8f - 0.6f * __expf(-0.3f * (float)layer);
    float lam; { const float a = wave_sum(lp[lane] * lp[64 + lane]), c = wave_sum(lp[128 + lane] * lp[192 + lane]); lam = __expf(a) - __expf(c) + lam_init; }
    for (int unit = u_lo + F.vcu; unit < u_hi; unit += F.G) {
        const int row = unit >> 4, h = unit & 15; const bool meta = row >= MR; const int b = (row >> 12) & 3, t = row & 4095;
        const int qpos = meta ? row - MR : NMETA + t, nk = meta ? NMETA : NMETA + 64 * ((t >> 6) + 1);
        const float slope2 = exp2f(-0.5f * (float)(h + 1)) * LOG2E;
        if (tid < 128) qf[tid] = bf2f(P[(size_t)row * INC + C_BQ + h * 128 + tid]);
        __syncthreads();
        float m0 = -3.0e38f, m1 = -3.0e38f;
        for (int kp = tid; kp < nk; kp += 512) { const size_t krow = kp < NMETA ? (size_t)(MR + kp) : (size_t)b * SEQ + kp - NMETA; const bf16* kr = P + krow * INC + C_BK + h * 128;
            float s0 = 0.f, s1 = 0.f;
#pragma unroll
            for (int j = 0; j < 8; ++j) { const v4u a = *(const GAS v4u*)(kr + 8 * j), c = *(const GAS v4u*)(kr + 64 + 8 * j);
#pragma unroll
                for (int i = 0; i < 4; ++i) { s0 += qf[8 * j + 2 * i] * __uint_as_float(a[i] << 16) + qf[8 * j + 2 * i + 1] * __uint_as_float(a[i] & 0xffff0000u);
                                              s1 += qf[64 + 8 * j + 2 * i] * __uint_as_float(c[i] << 16) + qf[64 + 8 * j + 2 * i + 1] * __uint_as_float(c[i] & 0xffff0000u); } }
            const float bias = slope2 * fabsf((float)(qpos - kp)); s0 -= bias; s1 -= bias; sc[kp] = s0; sc[4112 + kp] = s1; m0 = fmaxf(m0, s0); m1 = fmaxf(m1, s1); }
        m0 = wave_max(m0); m1 = wave_max(m1); if (lane == 0) { red[wave] = m0; red[8 + wave] = m1; }
        __syncthreads();
        m0 = red[0]; m1 = red[8];
#pragma unroll
        for (int i = 1; i < 8; ++i) { m0 = fmaxf(m0, red[i]); m1 = fmaxf(m1, red[8 + i]); }
        float l0 = 0.f, l1 = 0.f;
        for (int kp = tid; kp < nk; kp += 512) { const float p0 = exp2f(sc[kp] - m0), p1 = exp2f(sc[4112 + kp] - m1); sc[kp] = p0; sc[4112 + kp] = p1; l0 += p0; l1 += p1; }
        l0 = wave_sum(l0); l1 = wave_sum(l1); if (lane == 0) { red[16 + wave] = l0; red[24 + wave] = l1; }
        __syncthreads();
        l0 = 0.f; l1 = 0.f;
#pragma unroll
        for (int i = 0; i < 8; ++i) { l0 += red[16 + i]; l1 += red[24 + i]; }
        { const int c = tid >> 8, kq = (tid >> 6) & 3, ep = tid & 63; float a0 = 0.f, a1 = 0.f;
            for (int kp = kq; kp < nk; kp += 4) { const size_t krow = kp < NMETA ? (size_t)(MR + kp) : (size_t)b * SEQ + kp - NMETA;
                const unsigned vv = *(const GAS unsigned*)(P + krow * INC + C_BV + h * 128 + 2 * ep); const float p = sc[c * 4112 + kp];
                a0 += p * __uint_as_float(vv << 16); a1 += p * __uint_as_float(vv & 0xffff0000u); }
            pvr[(c * 4 + kq) * 128 + 2 * ep] = a0; pvr[(c * 4 + kq) * 128 + 2 * ep + 1] = a1; }
        __syncthreads();
        float o = 0.f;
        if (tid < 128) { float o0 = 0.f, o1 = 0.f;
#pragma unroll
            for (int kq = 0; kq < 4; ++kq) { o0 += pvr[kq * 128 + tid]; o1 += pvr[(4 + kq) * 128 + tid]; }
            o = o0 / l0 - lam * (o1 / l1);
            const float ss = wave_sum(o * o); if (lane == 0) red[32 + wave] = ss; }
        __syncthreads();
        if (tid < 128) { const float ss = red[32] + red[33]; const float y = o * (1.0f / sqrtf(ss * (1.0f / 128.0f) + EPS)) * og[tid] * (1.0f - lam_init);
            O[(size_t)row * DM + AW + h * 128 + tid] = (bf16)f2bf(y); }
        __syncthreads();
    }
}
namespace fa {
typedef short bf16x8 __attribute__((ext_vector_type(8)));
typedef short s16x4 __attribute__((ext_vector_type(4)));
typedef float f32x16 __attribute__((ext_vector_type(16)));
typedef unsigned u32x4 __attribute__((ext_vector_type(4)));
typedef float f32x2_t __attribute__((ext_vector_type(2))); typedef __bf16 bf16x2_t __attribute__((ext_vector_type(2)));
typedef short v4i16_t __attribute__((ext_vector_type(4)));
constexpr int SLOTB = 32768, NSLOT = 4;
constexpr int L_WSF = NSLOT * SLOTB;
constexpr int L_X = 0, L_OST = 65536;
constexpr float THR = 6.0f;
__device__ __forceinline__ int CR(int r) { return (r & 3) + 8 * (r >> 2); }
__device__ __forceinline__ void glds16(const void* gsrc, unsigned lds_dst) { unsigned keep;
    asm volatile("s_mov_b32 %0, m0\n\ts_mov_b32 m0, %2\n\ts_nop 0\n\tglobal_load_lds_dwordx4 %1, off\n\ts_mov_b32 m0, %0" : "=&s"(keep) : "v"(gsrc), "s"(lds_dst) : "memory"); }
__device__ __forceinline__ unsigned cvtpk(float lo, float hi) { f32x2_t v = {lo, hi}; bf16x2_t b = __builtin_convertvector(v, bf16x2_t); return __builtin_bit_cast(unsigned, b); }
__device__ __forceinline__ s16x4 vtr(const LAS char* p) { return __builtin_bit_cast(s16x4, __builtin_amdgcn_ds_read_tr16_b64_v4i16((LAS v4i16_t*)p)); }
__device__ __forceinline__ float hmax32(float v) { auto rr = __builtin_amdgcn_permlane32_swap(__float_as_uint(v), __float_as_uint(v), false, false); return fmaxf(__uint_as_float(rr[0]), __uint_as_float(rr[1])); }
__device__ __forceinline__ float hsum32(float v) { auto rr = __builtin_amdgcn_permlane32_swap(__float_as_uint(v), __float_as_uint(v), false, false); return __uint_as_float(rr[0]) + __uint_as_float(rr[1]); }
#define FA_WAIT_BAR(N) asm volatile("s_waitcnt vmcnt(" #N ") lgkmcnt(0)\n\ts_barrier" ::: "memory")

__device__ __forceinline__ void attn_unit(const bf16* P, bf16* O, int b, int h, int qb, float lam, float lam_init, float skipnum, const float* og, LAS unsigned char* lds) {
    int tid_ = threadIdx.x; asm volatile("" : "+v"(tid_));
    const int lane = tid_ & 63, r32 = lane & 31, hi = lane >> 5, wid = __builtin_amdgcn_readfirstlane(tid_ >> 6), c = wid >> 2, rg = wid & 3;
    const float slope2 = __uint_as_float(__builtin_amdgcn_readfirstlane(__float_as_uint(exp2f(-0.5f * (float)(h + 1)) * LOG2E)));
    const float sl2 = 2.f * slope2, sl3 = 3.f * slope2, sl8 = 8.f * slope2, sl16 = 16.f * slope2, sl24 = 24.f * slope2, sl32 = 32.f * slope2;
    const unsigned lds0 = (unsigned)(uintptr_t)lds;
    const float dskip = skipnum / slope2;
    int jmin = (int)ceilf(((float)(128 * qb - 63) - dskip) * (1.0f / 64.0f)); jmin = jmin < 0 ? 0 : jmin;
    const bool has_meta = (jmin == 0) && ((float)(128 * qb + 1) <= dskip);
    const int NTr = 2 * qb + 2 - jmin, NT = __builtin_amdgcn_readfirstlane(NTr + (has_meta ? 1 : 0)), jown = 2 * qb + (rg >> 1);
    const size_t rowb = (size_t)b * SEQ;
    const float qposl = (float)(NMETA + qb * 128 + rg * 32 + r32);
    const int dk_row = 8 * wid + (lane >> 3), dk_col = C_BK + h * 128 + (((lane & 7) ^ ((dk_row >> 1) & 7)) << 3);
    int dv_row[2], dv_col[2];
#pragma unroll
    for (int pp = 0; pp < 2; ++pp) { const int pv = 2 * wid + pp; dv_row[pp] = 8 * (pv & 7) + (lane >> 3); dv_col[pp] = C_BV + h * 128 + (pv >> 3) * 64 + (((lane & 7) ^ (((dv_row[pp] >> 1) & 1) << 2)) << 3); }
#define FA_DMA(i_) do { const int i__ = (i_); const bool meta__ = (i__ >= NTr); const int j__ = 2 * qb + 1 - i__; const unsigned sl__ = lds0 + (unsigned)((i__ & (NSLOT - 1)) * SLOTB); \
        const size_t rk__ = meta__ ? (size_t)(MR + (dk_row & 15)) : rowb + 64 * j__ + dk_row; \
        glds16(P + rk__ * INC + dk_col, (unsigned)__builtin_amdgcn_readfirstlane(sl__ + wid * 1024)); \
        glds16(P + rk__ * INC + dk_col + 64, (unsigned)__builtin_amdgcn_readfirstlane(sl__ + 8192 + wid * 1024)); \
        _Pragma("unroll") for (int pp = 0; pp < 2; ++pp) { const size_t rv__ = meta__ ? (size_t)(MR + (dv_row[pp] & 15)) : rowb + 64 * j__ + dv_row[pp]; \
            glds16(P + rv__ * INC + dv_col[pp], (unsigned)__builtin_amdgcn_readfirstlane(sl__ + 16384 + (2 * wid + pp) * 1024)); } } while (0)
    asm volatile("s_waitcnt vmcnt(0)" ::: "memory");
    bf16x8 qf[4];
    { const bf16* Qw = P + (rowb + qb * 128 + rg * 32 + r32) * INC + C_BQ + h * 128 + c * 64 + hi * 8;
#pragma unroll
      for (int d0 = 0; d0 < 4; ++d0) qf[d0] = *(const GAS bf16x8*)(Qw + d0 * 16); }
    FA_DMA(0); FA_DMA(1);
    f32x16 o[4];
#pragma unroll
    for (int d0 = 0; d0 < 4; ++d0)
#pragma unroll
        for (int r = 0; r < 16; ++r) o[d0][r] = 0.f;
    float mhat = -32.f, lsum = 0.f;
    LAS float* wsf = (LAS float*)(lds + L_WSF) + wid * 64;
    const LAS char* ldsc = (const LAS char*)lds;
    const int km7 = (r32 >> 1) & 7;
    int vbo0, vbo1; { const int q_ = (lane & 15) >> 2, p_ = lane & 3, blk_ = (lane >> 4) & 1, sw_ = ((q_ >> 1) & 1) << 2;
        vbo0 = (4 * hi + q_) * 128 + (((2 * blk_ + (p_ >> 1)) ^ sw_) << 4) + (p_ & 1) * 8; vbo1 = (4 * hi + q_) * 128 + (((4 + 2 * blk_ + (p_ >> 1)) ^ sw_) << 4) + (p_ & 1) * 8; }
    for (int i = 0; i < NT; ++i) {
        const int slot = (i & (NSLOT - 1)) * SLOTB;
        if ((i & 1) == 0) { FA_WAIT_BAR(0);
            if (i + 2 < NT) FA_DMA(i + 2);
            if (i + 3 < NT) FA_DMA(i + 3); }
        const bool meta = (i >= NTr); const int j = 2 * qb + 1 - i;
        if (!meta && j > jown) continue;
        const bool general = meta || (j == jown);
        const LAS char* Ks = ldsc + slot + c * 8192 + r32 * 128; asm volatile("" : "+v"(Ks));
        const float kvpos = meta ? 0.f : (float)(NMETA + 64 * j);
        f32x16 p0, p1;
        if (!general) { const float base = slope2 * (kvpos + (float)(4 * hi) - qposl) - mhat;
            const float t0 = base, t1 = base + slope2, t2 = base + sl2, t3 = base + sl3;
            p0[0] = t0; p0[1] = t1; p0[2] = t2; p0[3] = t3;
            p0[4] = t0 + sl8; p0[5] = t1 + sl8; p0[6] = t2 + sl8; p0[7] = t3 + sl8;
            p0[8] = t0 + sl16; p0[9] = t1 + sl16; p0[10] = t2 + sl16; p0[11] = t3 + sl16;
            p0[12] = t0 + sl24; p0[13] = t1 + sl24; p0[14] = t2 + sl24; p0[15] = t3 + sl24;
#pragma unroll
            for (int r = 0; r < 16; ++r) p1[r] = p0[r] + sl32; }
        else {
#pragma unroll
            for (int r = 0; r < 16; ++r) { p0[r] = 0.f; p1[r] = 0.f; } }
        { bf16x8 kf[8];
#pragma unroll
          for (int d0 = 0; d0 < 4; ++d0) { const int ko = ((2 * d0 + hi) ^ km7) << 4; kf[2 * d0] = *(const LAS bf16x8*)(Ks + ko); kf[2 * d0 + 1] = *(const LAS bf16x8*)(Ks + ko + 4096); }
          __builtin_amdgcn_sched_barrier(0);
#pragma unroll
          for (int d0 = 0; d0 < 4; ++d0) { p0 = __builtin_amdgcn_mfma_f32_32x32x16_bf16(kf[2 * d0], qf[d0], p0, 0, 0, 0); p1 = __builtin_amdgcn_mfma_f32_32x32x16_bf16(kf[2 * d0 + 1], qf[d0], p1, 0, 0, 0); }
          __builtin_amdgcn_sched_barrier(0); }
        if (general) {
#pragma unroll
            for (int r = 0; r < 16; ++r) { const float dq = qposl - kvpos - (float)(4 * hi);
                p0[r] = p0[r] - slope2 * fabsf(dq - (float)CR(r)) - mhat; p1[r] = p1[r] - slope2 * fabsf(dq - (float)(CR(r) + 32)) - mhat; }
            if (meta) {
#pragma unroll
                for (int r = 0; r < 16; ++r) { if (4 * hi + CR(r) >= NMETA) p0[r] = -1.0e30f; p1[r] = -1.0e30f; } }
        }
        float rm = fmaxf(p0[0], p1[0]);
#pragma unroll
        for (int r = 1; r < 16; ++r) rm = fmaxf(rm, fmaxf(p0[r], p1[r]));
        rm = hmax32(rm);
        if (__any(rm > THR)) { const float dl = fmaxf(rm, 0.f); mhat += dl;
#pragma unroll
            for (int r = 0; r < 16; ++r) { p0[r] -= dl; p1[r] -= dl; }
            const float f = exp2f(-dl); lsum *= f; if (hi == 0) wsf[r32] = f;
            LDS_WAIT();
#pragma unroll
            for (int r = 0; r < 16; ++r) { const float fr = wsf[CR(r) + 4 * hi];
#pragma unroll
                for (int d0 = 0; d0 < 4; ++d0) o[d0][r] *= fr; }
            LDS_WAIT(); }
        const LAS char* Vs0 = ldsc + slot + 16384 + vbo0; asm volatile("" : "+v"(Vs0)); const LAS char* Vs1 = ldsc + slot + 16384 + vbo1; asm volatile("" : "+v"(Vs1));
#define FA_VRD(dst, d0_, s_) do { const LAS char* vp_ = (((d0_) & 1) ? Vs1 : Vs0) + ((d0_) >> 1) * 8192 + (s_) * 2048; const s16x4 lo_ = vtr(vp_), hh_ = vtr(vp_ + 1024); dst = (bf16x8){lo_[0], lo_[1], lo_[2], lo_[3], hh_[0], hh_[1], hh_[2], hh_[3]}; } while (0)
#define FA_EX(P, i) do { P[i] = __builtin_amdgcn_exp2f(P[i]); ls += P[i]; } while (0)
#define FA_PK(P, B) __builtin_bit_cast(bf16x8, (u32x4){cvtpk(P[B], P[B + 1]), cvtpk(P[B + 2], P[B + 3]), cvtpk(P[B + 4], P[B + 5]), cvtpk(P[B + 6], P[B + 7])})
        float ls = 0.f; bf16x8 pa, pan, vf0, vf1, vf2;
        FA_VRD(vf0, 0, 0); FA_VRD(vf1, 1, 0);
        FA_EX(p0, 0); FA_EX(p0, 1); FA_EX(p0, 2); FA_EX(p0, 3); FA_EX(p0, 4); FA_EX(p0, 5); FA_EX(p0, 6); FA_EX(p0, 7); pa = FA_PK(p0, 0);
        __builtin_amdgcn_sched_barrier(0);
        FA_VRD(vf2, 2, 0); o[0] = __builtin_amdgcn_mfma_f32_32x32x16_bf16(pa, vf0, o[0], 0, 0, 0); FA_EX(p0, 8); FA_EX(p0, 9); __builtin_amdgcn_sched_barrier(0);
        FA_VRD(vf0, 3, 0); o[1] = __builtin_amdgcn_mfma_f32_32x32x16_bf16(pa, vf1, o[1], 0, 0, 0); FA_EX(p0, 10); FA_EX(p0, 11); __builtin_amdgcn_sched_barrier(0);
        FA_VRD(vf1, 0, 1); o[2] = __builtin_amdgcn_mfma_f32_32x32x16_bf16(pa, vf2, o[2], 0, 0, 0); FA_EX(p0, 12); FA_EX(p0, 13); __builtin_amdgcn_sched_barrier(0);
        FA_VRD(vf2, 1, 1); o[3] = __builtin_amdgcn_mfma_f32_32x32x16_bf16(pa, vf0, o[3], 0, 0, 0); FA_EX(p0, 14); FA_EX(p0, 15); pan = FA_PK(p0, 8); __builtin_amdgcn_sched_barrier(0);
        pa = pan;
        FA_VRD(vf0, 2, 1); o[0] = __builtin_amdgcn_mfma_f32_32x32x16_bf16(pa, vf1, o[0], 0, 0, 0); FA_EX(p1, 0); FA_EX(p1, 1); __builtin_amdgcn_sched_barrier(0);
        FA_VRD(vf1, 3, 1); o[1] = __builtin_amdgcn_mfma_f32_32x32x16_bf16(pa, vf2, o[1], 0, 0, 0); FA_EX(p1, 2); FA_EX(p1, 3); __builtin_amdgcn_sched_barrier(0);
        FA_VRD(vf2, 0, 2); o[2] = __builtin_amdgcn_mfma_f32_32x32x16_bf16(pa, vf0, o[2], 0, 0, 0); FA_EX(p1, 4); FA_EX(p1, 5); __builtin_amdgcn_sched_barrier(0);
        FA_VRD(vf0, 1, 2); o[3] = __builtin_amdgcn_mfma_f32_32x32x16_bf16(pa, vf1, o[3], 0, 0, 0); FA_EX(p1, 6); FA_EX(p1, 7); pan = FA_PK(p1, 0); __builtin_amdgcn_sched_barrier(0);
        pa = pan;
        FA_VRD(vf1, 2, 2); o[0] = __builtin_amdgcn_mfma_f32_32x32x16_bf16(pa, vf2, o[0], 0, 0, 0); FA_EX(p1, 8); FA_EX(p1, 9); __builtin_amdgcn_sched_barrier(0);
        FA_VRD(vf2, 3, 2); o[1] = __builtin_amdgcn_mfma_f32_32x32x16_bf16(pa, vf0, o[1], 0, 0, 0); FA_EX(p1, 10); FA_EX(p1, 11); __builtin_amdgcn_sched_barrier(0);
        FA_VRD(vf0, 0, 3); o[2] = __builtin_amdgcn_mfma_f32_32x32x16_bf16(pa, vf1, o[2], 0, 0, 0); FA_EX(p1, 12); FA_EX(p1, 13); __builtin_amdgcn_sched_barrier(0);
        FA_VRD(vf1, 1, 3); o[3] = __builtin_amdgcn_mfma_f32_32x32x16_bf16(pa, vf2, o[3], 0, 0, 0); FA_EX(p1, 14); FA_EX(p1, 15); pan = FA_PK(p1, 8); __builtin_amdgcn_sched_barrier(0);
        pa = pan;
        FA_VRD(vf2, 2, 3); o[0] = __builtin_amdgcn_mfma_f32_32x32x16_bf16(pa, vf0, o[0], 0, 0, 0); __builtin_amdgcn_sched_barrier(0);
        FA_VRD(vf0, 3, 3); o[1] = __builtin_amdgcn_mfma_f32_32x32x16_bf16(pa, vf1, o[1], 0, 0, 0); __builtin_amdgcn_sched_barrier(0);
        o[2] = __builtin_amdgcn_mfma_f32_32x32x16_bf16(pa, vf2, o[2], 0, 0, 0); __builtin_amdgcn_sched_barrier(0);
        o[3] = __builtin_amdgcn_mfma_f32_32x32x16_bf16(pa, vf0, o[3], 0, 0, 0); __builtin_amdgcn_sched_barrier(0);
        lsum += ls;
#undef FA_VRD
#undef FA_EX
#undef FA_PK
    }
    lsum = hsum32(lsum);
    FA_WAIT_BAR(0);
    { const float inv = (c == 0 ? 1.0f : -lam) / lsum; if (hi == 0) wsf[r32] = inv; LDS_WAIT();
#pragma unroll
      for (int r = 0; r < 16; ++r) { const float fr = wsf[CR(r) + 4 * hi];
#pragma unroll
          for (int d0 = 0; d0 < 4; ++d0) o[d0][r] *= fr; } }
    LAS float* X = (LAS float*)(lds + L_X) + rg * 4096 + lane;
    if (c == 1) {
#pragma unroll
        for (int d0 = 0; d0 < 4; ++d0)
#pragma unroll
            for (int r = 0; r < 16; ++r) X[(d0 * 16 + r) * 64] = o[d0][r]; }
    FA_WAIT_BAR(0);
    if (c == 0) {
        float rs[16];
#pragma unroll
        for (int r = 0; r < 16; ++r) { float ss = 0.f;
#pragma unroll
            for (int d0 = 0; d0 < 4; ++d0) { o[d0][r] += X[(d0 * 16 + r) * 64]; ss += o[d0][r] * o[d0][r]; }
#pragma unroll
            for (int m = 1; m < 32; m <<= 1) ss += __shfl_xor(ss, m);
            rs[r] = __builtin_amdgcn_rsqf(ss * (1.0f / 128.0f) + EPS) * (1.0f - lam_init); }
        LAS bf16* stg = (LAS bf16*)(lds + L_OST + rg * 8192);
#pragma unroll
        for (int d0 = 0; d0 < 4; ++d0) { const float g = og[d0 * 32 + r32];
#pragma unroll
            for (int r = 0; r < 16; ++r) stg[(CR(r) + 4 * hi) * 128 + d0 * 32 + r32] = (bf16)f2bf(o[d0][r] * rs[r] * g); }
        LDS_WAIT();
        bf16* Ow = O + (rowb + qb * 128 + rg * 32) * DM + AW + h * 128;
#pragma unroll
        for (int k = 0; k < 8; ++k) { const int row = k * 4 + (lane >> 4), ch = lane & 15; const u32x4 v = *(const LAS u32x4*)(stg + row * 128 + ch * 8); *(GAS u32x4*)(Ow + (size_t)row * DM + ch * 8) = v; }
    }
    FA_WAIT_BAR(0);
#undef FA_DMA
}
__device__ __forceinline__ void attn_phase(Frame& F, const bf16* P, bf16* O, const float* lp, const float* og, int layer) {
    const float lam_init = 0.8f - 0.6f * __expf(-0.3f * (float)layer);
    float lam; { const int lane = threadIdx.x & 63; const float a = wave_sum(lp[lane] * lp[64 + lane]), cc = wave_sum(lp[128 + lane] * lp[192 + lane]); lam = __expf(a) - __expf(cc) + lam_init; }
    for (int v = F.vcu; v < 256; v += F.G) { const int bh = v >> 2, s = v & 3;
        for (int k = 0; k < 8; ++k) { const int qb = (k & 1) ? 31 - 4 * (k >> 1) - s : 4 * (k >> 1) + s;
            attn_unit(P, O, bh >> 4, bh & 15, qb, lam, lam_init, 1.0e30f, og, F.lds + RING_OFF); } }
}
#undef FA_WAIT_BAR
}
namespace hg {
typedef short bf16x8 __attribute__((ext_vector_type(8)));
typedef float f32x16 __attribute__((ext_vector_type(16)));
typedef unsigned u32x2 __attribute__((ext_vector_type(2)));
constexpr int RQ = 272, RS = 144;
constexpr int L_QED = 0, L_KED = L_QED + 64 * RQ, L_QB = L_KED + 64 * RQ, L_QEO = L_QB + 64 * RQ, L_KEO = L_QEO + 32 * RQ, L_KDT = L_KEO + 32 * RQ, L_VT = L_KDT + 128 * RS,
              L_A = L_VT + 128 * RS, L_ST = L_A + 64 * RS, L_SEG = L_ST + 128 * RQ, L_BL = L_SEG + 4096, L_END = L_BL + 512;
#define HG_BAR() do { asm volatile("s_waitcnt lgkmcnt(0)" ::: "memory"); __builtin_amdgcn_s_barrier(); asm volatile("" ::: "memory"); } while (0)
__device__ __forceinline__ float bflo(unsigned u) { return __uint_as_float(u << 16); }
__device__ __forceinline__ float bfhi(unsigned u) { return __uint_as_float(u & 0xffff0000u); }

__device__ __forceinline__ void hgrn_chain(const bf16* P, bf16* O, const float* lbraw, const float* og, int layer, int b, int h, LAS unsigned char* lds) {
    int tid_ = threadIdx.x; asm volatile("" : "+v"(tid_));
    const int tid = tid_, lane = tid & 63, wid = __builtin_amdgcn_readfirstlane(tid >> 6);
    const int d0 = 2 * lane, to = wid, half = wid >> 2;
    for (int i = tid; i < 128 * RQ / 4; i += 512) ((LAS unsigned*)(lds + L_ST))[i] = 0u;
    f32x16 sacc[4];
#pragma unroll
    for (int dt = 0; dt < 4; ++dt)
#pragma unroll
        for (int r = 0; r < 16; ++r) sacc[dt][r] = 0.f;
    const size_t rowb = (size_t)b * SEQ;
    unsigned qraw[8], fraw[8], vraw[8];
#define HG_ROW(s_, t_) ((s_) == 0 ? (size_t)(MR + ((t_) & 15)) : rowb + (size_t)((s_) - 1) * 64 + (t_))
#define HG_LOAD(s_) do { _Pragma("unroll") for (int i = 0; i < 8; ++i) { const bf16* rp = P + HG_ROW(s_, 8 * to + i) * INC + h * 128 + d0; \
        qraw[i] = *(const GAS unsigned*)(rp + C_AQ); fraw[i] = *(const GAS unsigned*)(rp + C_AF); vraw[i] = *(const GAS unsigned*)(rp + C_AI); } } while (0)
    HG_LOAD(0);
    HG_BAR();
    for (int s = 0; s <= 64; ++s) {
        const bool meta = (s == 0);
        float bl[2][8], qv[2][8], kv[2][8]; unsigned vv[8];
        { float run0 = 0.f, run1 = 0.f;
#pragma unroll
          for (int i = 0; i < 8; ++i) { const bool pad = meta && (8 * to + i >= NMETA);
              float lf0 = bflo(fraw[i]), lf1 = bfhi(fraw[i]);
              float k0 = 1.0f - __expf(lf0), k1 = 1.0f - __expf(lf1);
              float q0 = bflo(qraw[i]), q1 = bfhi(qraw[i]); unsigned v = vraw[i];
              if (pad) { lf0 = 0.f; lf1 = 0.f; k0 = 0.f; k1 = 0.f; q0 = 0.f; q1 = 0.f; v = 0u; }
              run0 += lf0; run1 += lf1; bl[0][i] = run0; bl[1][i] = run1; qv[0][i] = q0; qv[1][i] = q1; kv[0][i] = k0; kv[1][i] = k1; vv[i] = v; }
          *(LAS f32x2*)(lds + L_SEG + (to * 128 + d0) * 4) = (f32x2){run0, run1}; }
        if (s < 64) HG_LOAD(s + 1);
        HG_BAR();
        {   f32x2 sg[8];
#pragma unroll
            for (int j = 0; j < 8; ++j) sg[j] = *(const LAS f32x2*)(lds + L_SEG + (j * 128 + d0) * 4);
            f32x2 off = {0.f, 0.f};
#pragma unroll
            for (int j = 0; j < 8; ++j) if (j < to) off += sg[j];
            const f32x2 b15 = sg[0] + sg[1], b31 = b15 + sg[2] + sg[3], b47 = b31 + sg[4] + sg[5], blast = b47 + sg[6] + sg[7];
            const f32x2 ref = half ? b47 : b15;
            if (to == 0) *(LAS f32x2*)(lds + L_BL + d0 * 4) = blast;
            float cqb[2], cx[2], ckd[2];
#pragma unroll
            for (int dd = 0; dd < 2; ++dd) { cqb[dd] = __expf(ref[dd]); cx[dd] = half ? __expf(ref[dd] - b31[dd]) : __expf(b31[dd] - ref[dd]); ckd[dd] = __expf(blast[dd] - ref[dd]); }
            unsigned kdp[2][4];
#pragma unroll
            for (int i = 0; i < 8; ++i) { const int t = 8 * to + i;
                float qe[2], ke[2];
#pragma unroll
                for (int dd = 0; dd < 2; ++dd) { const float E = __expf(__builtin_amdgcn_fmed3f(bl[dd][i] + off[dd] - ref[dd], -80.0f, 80.0f)); qe[dd] = qv[dd][i] * E; ke[dd] = kv[dd][i] * __builtin_amdgcn_rcpf(E); }
                *(LAS unsigned*)(lds + L_QED + t * RQ + d0 * 2) = pk2(qe[0], qe[1]);
                *(LAS unsigned*)(lds + L_KED + t * RQ + d0 * 2) = pk2(ke[0], ke[1]);
                *(LAS unsigned*)(lds + L_QB + t * RQ + d0 * 2) = pk2(qe[0] * cqb[0], qe[1] * cqb[1]);
                if (half) *(LAS unsigned*)(lds + L_QEO + (t - 32) * RQ + d0 * 2) = pk2(qe[0] * cx[0], qe[1] * cx[1]);
                else      *(LAS unsigned*)(lds + L_KEO + t * RQ + d0 * 2) = pk2(ke[0] * cx[0], ke[1] * cx[1]);
                const float kd0 = ke[0] * ckd[0], kd1 = ke[1] * ckd[1];
                if (i & 1) { kdp[0][i >> 1] |= f2bf(kd0) << 16; kdp[1][i >> 1] |= f2bf(kd1) << 16; } else { kdp[0][i >> 1] = f2bf(kd0); kdp[1][i >> 1] = f2bf(kd1); } }
#pragma unroll
            for (int dd = 0; dd < 2; ++dd) *(LAS v4u*)(lds + L_KDT + (d0 + dd) * RS + to * 16) = (v4u){kdp[dd][0], kdp[dd][1], kdp[dd][2], kdp[dd][3]};
            v4u vt0, vt1;
#pragma unroll
            for (int i = 0; i < 4; ++i) { vt0[i] = (vv[2 * i] & 0xffffu) | (vv[2 * i + 1] << 16); vt1[i] = (vv[2 * i] >> 16) | (vv[2 * i + 1] & 0xffff0000u); }
            *(LAS v4u*)(lds + L_VT + d0 * RS + to * 16) = vt0; *(LAS v4u*)(lds + L_VT + (d0 + 1) * RS + to * 16) = vt1;
        }
        HG_BAR();
        if (wid >= 4) {
            const int w = wid - 4, r32 = lane & 31, hi = lane >> 5;
            if (w < 3) {
                const LAS unsigned char* qs = lds + (w == 2 ? L_QEO : L_QED + (w == 1 ? 32 * RQ : 0)) + r32 * RQ + hi * 16;
                const LAS unsigned char* ks_ = lds + (w == 2 ? L_KEO : L_KED + (w == 1 ? 32 * RQ : 0)) + r32 * RQ + hi * 16;
                f32x16 a;
#pragma unroll
                for (int r = 0; r < 16; ++r) a[r] = 0.f;
                { bf16x8 ka[8], qa[8];
#pragma unroll
                  for (int k = 0; k < 8; ++k) { ka[k] = *(const LAS bf16x8*)(ks_ + k * 32); qa[k] = *(const LAS bf16x8*)(qs + k * 32); }
#pragma unroll
                  for (int k = 0; k < 8; ++k) a = __builtin_amdgcn_mfma_f32_32x32x16_bf16(ka[k], qa[k], a, 0, 0, 0); }
                const int t0 = w ? 32 : 0, s0 = (w == 1) ? 32 : 0;
#pragma unroll
                for (int g = 0; g < 4; ++g) { float v4[4];
#pragma unroll
                    for (int i = 0; i < 4; ++i) { const int sloc = 8 * g + 4 * hi + i; v4[i] = (w != 2 && sloc > r32) ? 0.f : a[4 * g + i]; }
                    *(LAS u32x2*)(lds + L_A + (t0 + r32) * RS + (s0 + 8 * g + 4 * hi) * 2) = (u32x2){pk2(v4[0], v4[1]), pk2(v4[2], v4[3])}; }
            }
#pragma unroll
            for (int r = 0; r < 16; ++r) { const float dec = __expf(*(const LAS float*)(lds + L_BL + (32 * w + (r & 3) + 8 * (r >> 2) + 4 * hi) * 4));
#pragma unroll
                for (int et = 0; et < 4; ++et) sacc[et][r] *= dec; }
            {
                const LAS unsigned char* kdp = lds + L_KDT + (32 * w + r32) * RS + hi * 16; const LAS unsigned char* vtp = lds + L_VT + r32 * RS + hi * 16;
#define HG_VT(dst, et_, k_) dst = *(const LAS bf16x8*)(vtp + (et_) * 32 * RS + (k_) * 32)
                bf16x8 af, afn, b0, b1, b2;
                af = *(const LAS bf16x8*)(kdp); HG_VT(b0, 0, 0); HG_VT(b1, 1, 0);
                __builtin_amdgcn_sched_barrier(0);
                HG_VT(b2, 2, 0); sacc[0] = __builtin_amdgcn_mfma_f32_32x32x16_bf16(af, b0, sacc[0], 0, 0, 0); __builtin_amdgcn_sched_barrier(0);
                HG_VT(b0, 3, 0); afn = *(const LAS bf16x8*)(kdp + 32); sacc[1] = __builtin_amdgcn_mfma_f32_32x32x16_bf16(af, b1, sacc[1], 0, 0, 0); __builtin_amdgcn_sched_barrier(0);
                HG_VT(b1, 0, 1); sacc[2] = __builtin_amdgcn_mfma_f32_32x32x16_bf16(af, b2, sacc[2], 0, 0, 0); __builtin_amdgcn_sched_barrier(0);
                HG_VT(b2, 1, 1); sacc[3] = __builtin_amdgcn_mfma_f32_32x32x16_bf16(af, b0, sacc[3], 0, 0, 0); __builtin_amdgcn_sched_barrier(0);
                af = afn;
                HG_VT(b0, 2, 1); sacc[0] = __builtin_amdgcn_mfma_f32_32x32x16_bf16(af, b1, sacc[0], 0, 0, 0); __builtin_amdgcn_sched_barrier(0);
                HG_VT(b1, 3, 1); afn = *(const LAS bf16x8*)(kdp + 64); sacc[1] = __builtin_amdgcn_mfma_f32_32x32x16_bf16(af, b2, sacc[1], 0, 0, 0); __builtin_amdgcn_sched_barrier(0);
                HG_VT(b2, 0, 2); sacc[2] = __builtin_amdgcn_mfma_f32_32x32x16_bf16(af, b0, sacc[2], 0, 0, 0); __builtin_amdgcn_sched_barrier(0);
                HG_VT(b0, 1, 2); sacc[3] = __builtin_amdgcn_mfma_f32_32x32x16_bf16(af, b1, sacc[3], 0, 0, 0); __builtin_amdgcn_sched_barrier(0);
                af = afn;
                HG_VT(b1, 2, 2); sacc[0] = __builtin_amdgcn_mfma_f32_32x32x16_bf16(af, b2, sacc[0], 0, 0, 0); __builtin_amdgcn_sched_barrier(0);
                HG_VT(b2, 3, 2); afn = *(const LAS bf16x8*)(kdp + 96); sacc[1] = __builtin_amdgcn_mfma_f32_32x32x16_bf16(af, b0, sacc[1], 0, 0, 0); __builtin_amdgcn_sched_barrier(0);
                HG_VT(b0, 0, 3); sacc[2] = __builtin_amdgcn_mfma_f32_32x32x16_bf16(af, b1, sacc[2], 0, 0, 0); __builtin_amdgcn_sched_barrier(0);
                HG_VT(b1, 1, 3); sacc[3] = __builtin_amdgcn_mfma_f32_32x32x16_bf16(af, b2, sacc[3], 0, 0, 0); __builtin_amdgcn_sched_barrier(0);
                af = afn;
                HG_VT(b2, 2, 3); sacc[0] = __builtin_amdgcn_mfma_f32_32x32x16_bf16(af, b0, sacc[0], 0, 0, 0); __builtin_amdgcn_sched_barrier(0);
                HG_VT(b0, 3, 3); sacc[1] = __builtin_amdgcn_mfma_f32_32x32x16_bf16(af, b1, sacc[1], 0, 0, 0); __builtin_amdgcn_sched_barrier(0);
                sacc[2] = __builtin_amdgcn_mfma_f32_32x32x16_bf16(af, b2, sacc[2], 0, 0, 0); __builtin_amdgcn_sched_barrier(0);
                sacc[3] = __builtin_amdgcn_mfma_f32_32x32x16_bf16(af, b0, sacc[3], 0, 0, 0); __builtin_amdgcn_sched_barrier(0);
#undef HG_VT
            }
            HG_BAR();
#pragma unroll
            for (int et = 0; et < 4; ++et)
#pragma unroll
                for (int g = 0; g < 4; ++g) *(LAS u32x2*)(lds + L_ST + (32 * et + r32) * RQ + (32 * w + 8 * g + 4 * hi) * 2) = (u32x2){pk2(sacc[et][4 * g], sacc[et][4 * g + 1]), pk2(sacc[et][4 * g + 2], sacc[et][4 * g + 3])};
        } else {
            const int t0 = 16 * wid, c15 = lane & 15, q4 = lane >> 4;
            const int t = t0 + c15; const bool valid = meta ? (t < NMETA && b == 0) : true;
            const size_t row = HG_ROW(s, t);
            u32x2 graw[8];
#pragma unroll
            for (int et = 0; et < 8; ++et) graw[et] = *(const GAS u32x2*)(P + row * INC + C_AG + h * 128 + 16 * et + 4 * q4);
            f32x4 oacc[8];
#pragma unroll
            for (int et = 0; et < 8; ++et) oacc[et] = (f32x4){0.f, 0.f, 0.f, 0.f};
            {
                const LAS unsigned char* stp = lds + L_ST + c15 * RQ + q4 * 16;
#define HG_ST(dst, et_, k_) dst = *(const LAS bf16x8*)(stp + (et_) * 16 * RQ + (k_) * 64)
                bf16x8 bq[4], a0, a1, a2, a3;
#pragma unroll
                for (int k = 0; k < 4; ++k) bq[k] = *(const LAS bf16x8*)(lds + L_QB + t * RQ + k * 64 + q4 * 16);
                HG_ST(a0, 0, 0); HG_ST(a1, 1, 0); HG_ST(a2, 2, 0);
                __builtin_amdgcn_sched_barrier(0);
                HG_ST(a3, 3, 0); oacc[0] = __builtin_amdgcn_mfma_f32_16x16x32_bf16(a0, bq[0], oacc[0], 0, 0, 0); __builtin_amdgcn_sched_barrier(0);
                HG_ST(a0, 4, 0); oacc[1] = __builtin_amdgcn_mfma_f32_16x16x32_bf16(a1, bq[0], oacc[1], 0, 0, 0); __builtin_amdgcn_sched_barrier(0);
                HG_ST(a1, 5, 0); oacc[2] = __builtin_amdgcn_mfma_f32_16x16x32_bf16(a2, bq[0], oacc[2], 0, 0, 0); __builtin_amdgcn_sched_barrier(0);
                HG_ST(a2, 6, 0); oacc[3] = __builtin_amdgcn_mfma_f32_16x16x32_bf16(a3, bq[0], oacc[3], 0, 0, 0); __builtin_amdgcn_sched_barrier(0);
                HG_ST(a3, 7, 0); oacc[4] = __builtin_amdgcn_mfma_f32_16x16x32_bf16(a0, bq[0], oacc[4], 0, 0, 0); __builtin_amdgcn_sched_barrier(0);
                HG_ST(a0, 0, 1); oacc[5] = __builtin_amdgcn_mfma_f32_16x16x32_bf16(a1, bq[0], oacc[5], 0, 0, 0); __builtin_amdgcn_sched_barrier(0);
                HG_ST(a1, 1, 1); oacc[6] = __builtin_amdgcn_mfma_f32_16x16x32_bf16(a2, bq[0], oacc[6], 0, 0, 0); __builtin_amdgcn_sched_barrier(0);
                HG_ST(a2, 2, 1); oacc[7] = __builtin_amdgcn_mfma_f32_16x16x32_bf16(a3, bq[0], oacc[7], 0, 0, 0); __builtin_amdgcn_sched_barrier(0);
                HG_ST(a3, 3, 1); oacc[0] = __builtin_amdgcn_mfma_f32_16x16x32_bf16(a0, bq[1], oacc[0], 0, 0, 0); __builtin_amdgcn_sched_barrier(0);
                HG_ST(a0, 4, 1); oacc[1] = __builtin_amdgcn_mfma_f32_16x16x32_bf16(a1, bq[1], oacc[1], 0, 0, 0); __builtin_amdgcn_sched_barrier(0);
                HG_ST(a1, 5, 1); oacc[2] = __builtin_amdgcn_mfma_f32_16x16x32_bf16(a2, bq[1], oacc[2], 0, 0, 0); __builtin_amdgcn_sched_barrier(0);
                HG_ST(a2, 6, 1); oacc[3] = __builtin_amdgcn_mfma_f32_16x16x32_bf16(a3, bq[1], oacc[3], 0, 0, 0); __builtin_amdgcn_sched_barrier(0);
                HG_ST(a3, 7, 1); oacc[4] = __builtin_amdgcn_mfma_f32_16x16x32_bf16(a0, bq[1], oacc[4], 0, 0, 0); __builtin_amdgcn_sched_barrier(0);
                HG_ST(a0, 0, 2); oacc[5] = __builtin_amdgcn_mfma_f32_16x16x32_bf16(a1, bq[1], oacc[5], 0, 0, 0); __builtin_amdgcn_sched_barrier(0);
                HG_ST(a1, 1, 2); oacc[6] = __builtin_amdgcn_mfma_f32_16x16x32_bf16(a2, bq[1], oacc[6], 0, 0, 0); __builtin_amdgcn_sched_barrier(0);
                HG_ST(a2, 2, 2); oacc[7] = __builtin_amdgcn_mfma_f32_16x16x32_bf16(a3, bq[1], oacc[7], 0, 0, 0); __builtin_amdgcn_sched_barrier(0);
                HG_ST(a3, 3, 2); oacc[0] = __builtin_amdgcn_mfma_f32_16x16x32_bf16(a0, bq[2], oacc[0], 0, 0, 0); __builtin_amdgcn_sched_barrier(0);
                HG_ST(a0, 4, 2); oacc[1] = __builtin_amdgcn_mfma_f32_16x16x32_bf16(a1, bq[2], oacc[1], 0, 0, 0); __builtin_amdgcn_sched_barrier(0);
                HG_ST(a1, 5, 2); oacc[2] = __builtin_amdgcn_mfma_f32_16x16x32_bf16(a2, bq[2], oacc[2], 0, 0, 0); __builtin_amdgcn_sched_barrier(0);
                HG_ST(a2, 6, 2); oacc[3] = __builtin_amdgcn_mfma_f32_16x16x32_bf16(a3, bq[2], oacc[3], 0, 0, 0); __builtin_amdgcn_sched_barrier(0);
                HG_ST(a3, 7, 2); oacc[4] = __builtin_amdgcn_mfma_f32_16x16x32_bf16(a0, bq[2], oacc[4], 0, 0, 0); __builtin_amdgcn_sched_barrier(0);
                HG_ST(a0, 0, 3); oacc[5] = __builtin_amdgcn_mfma_f32_16x16x32_bf16(a1, bq[2], oacc[5], 0, 0, 0); __builtin_amdgcn_sched_barrier(0);
                HG_ST(a1, 1, 3); oacc[6] = __builtin_amdgcn_mfma_f32_16x16x32_bf16(a2, bq[2], oacc[6], 0, 0, 0); __builtin_amdgcn_sched_barrier(0);
                HG_ST(a2, 2, 3); oacc[7] = __builtin_amdgcn_mfma_f32_16x16x32_bf16(a3, bq[2], oacc[7], 0, 0, 0); __builtin_amdgcn_sched_barrier(0);
                HG_ST(a3, 3, 3); oacc[0] = __builtin_amdgcn_mfma_f32_16x16x32_bf16(a0, bq[3], oacc[0], 0, 0, 0); __builtin_amdgcn_sched_barrier(0);
                HG_ST(a0, 4, 3); oacc[1] = __builtin_amdgcn_mfma_f32_16x16x32_bf16(a1, bq[3], oacc[1], 0, 0, 0); __builtin_amdgcn_sched_barrier(0);
                HG_ST(a1, 5, 3); oacc[2] = __builtin_amdgcn_mfma_f32_16x16x32_bf16(a2, bq[3], oacc[2], 0, 0, 0); __builtin_amdgcn_sched_barrier(0);
                HG_ST(a2, 6, 3); oacc[3] = __builtin_amdgcn_mfma_f32_16x16x32_bf16(a3, bq[3], oacc[3], 0, 0, 0); __builtin_amdgcn_sched_barrier(0);
                HG_ST(a3, 7, 3); oacc[4] = __builtin_amdgcn_mfma_f32_16x16x32_bf16(a0, bq[3], oacc[4], 0, 0, 0); __builtin_amdgcn_sched_barrier(0);
                oacc[5] = __builtin_amdgcn_mfma_f32_16x16x32_bf16(a1, bq[3], oacc[5], 0, 0, 0); __builtin_amdgcn_sched_barrier(0);
                oacc[6] = __builtin_amdgcn_mfma_f32_16x16x32_bf16(a2, bq[3], oacc[6], 0, 0, 0); __builtin_amdgcn_sched_barrier(0);
                oacc[7] = __builtin_amdgcn_mfma_f32_16x16x32_bf16(a3, bq[3], oacc[7], 0, 0, 0); __builtin_amdgcn_sched_barrier(0);
#undef HG_ST
            }
            HG_BAR();
            const int nks = (t0 < 32) ? 1 : 2;
            {
                const LAS unsigned char* vtq = lds + L_VT + c15 * RS + q4 * 16;
#define HG_VQ(dst, et_, k_) dst = *(const LAS bf16x8*)(vtq + (et_) * 16 * RS + (k_) * 64)
                bf16x8 a0, a1, a2, a3; const bf16x8 ba0 = *(const LAS bf16x8*)(lds + L_A + t * RS + q4 * 16), ba1 = *(const LAS bf16x8*)(lds + L_A + t * RS + 64 + q4 * 16);
                HG_VQ(a0, 0, 0); HG_VQ(a1, 1, 0); HG_VQ(a2, 2, 0);
                __builtin_amdgcn_sched_barrier(0);
                HG_VQ(a3, 3, 0); oacc[0] = __builtin_amdgcn_mfma_f32_16x16x32_bf16(a0, ba0, oacc[0], 0, 0, 0); __builtin_amdgcn_sched_barrier(0);
                HG_VQ(a0, 4, 0); oacc[1] = __builtin_amdgcn_mfma_f32_16x16x32_bf16(a1, ba0, oacc[1], 0, 0, 0); __builtin_amdgcn_sched_barrier(0);
                HG_VQ(a1, 5, 0); oacc[2] = __builtin_amdgcn_mfma_f32_16x16x32_bf16(a2, ba0, oacc[2], 0, 0, 0); __builtin_amdgcn_sched_barrier(0);
                HG_VQ(a2, 6, 0); oacc[3] = __builtin_amdgcn_mfma_f32_16x16x32_bf16(a3, ba0, oacc[3], 0, 0, 0); __builtin_amdgcn_sched_barrier(0);
                HG_VQ(a3, 7, 0); oacc[4] = __builtin_amdgcn_mfma_f32_16x16x32_bf16(a0, ba0, oacc[4], 0, 0, 0); __builtin_amdgcn_sched_barrier(0);
                if (nks == 2) { HG_VQ(a0, 0, 1); } oacc[5] = __builtin_amdgcn_mfma_f32_16x16x32_bf16(a1, ba0, oacc[5], 0, 0, 0); __builtin_amdgcn_sched_barrier(0);
                if (nks == 2) { HG_VQ(a1, 1, 1); } oacc[6] = __builtin_amdgcn_mfma_f32_16x16x32_bf16(a2, ba0, oacc[6], 0, 0, 0); __builtin_amdgcn_sched_barrier(0);
                if (nks == 2) { HG_VQ(a2, 2, 1); } oacc[7] = __builtin_amdgcn_mfma_f32_16x16x32_bf16(a3, ba0, oacc[7], 0, 0, 0); __builtin_amdgcn_sched_barrier(0);
                if (nks == 2) {
                    HG_VQ(a3, 3, 1); oacc[0] = __builtin_amdgcn_mfma_f32_16x16x32_bf16(a0, ba1, oacc[0], 0, 0, 0); __builtin_amdgcn_sched_barrier(0);
                    HG_VQ(a0, 4, 1); oacc[1] = __builtin_amdgcn_mfma_f32_16x16x32_bf16(a1, ba1, oacc[1], 0, 0, 0); __builtin_amdgcn_sched_barrier(0);
                    HG_VQ(a1, 5, 1); oacc[2] = __builtin_amdgcn_mfma_f32_16x16x32_bf16(a2, ba1, oacc[2], 0, 0, 0); __builtin_amdgcn_sched_barrier(0);
                    HG_VQ(a2, 6, 1); oacc[3] = __builtin_amdgcn_mfma_f32_16x16x32_bf16(a3, ba1, oacc[3], 0, 0, 0); __builtin_amdgcn_sched_barrier(0);
                    HG_VQ(a3, 7, 1); oacc[4] = __builtin_amdgcn_mfma_f32_16x16x32_bf16(a0, ba1, oacc[4], 0, 0, 0); __builtin_amdgcn_sched_barrier(0);
                    oacc[5] = __builtin_amdgcn_mfma_f32_16x16x32_bf16(a1, ba1, oacc[5], 0, 0, 0); __builtin_amdgcn_sched_barrier(0);
                    oacc[6] = __builtin_amdgcn_mfma_f32_16x16x32_bf16(a2, ba1, oacc[6], 0, 0, 0); __builtin_amdgcn_sched_barrier(0);
                    oacc[7] = __builtin_amdgcn_mfma_f32_16x16x32_bf16(a3, ba1, oacc[7], 0, 0, 0); __builtin_amdgcn_sched_barrier(0);
                }
#undef HG_VQ
            }
            float ss = 0.f;
#pragma unroll
            for (int et = 0; et < 8; ++et) { const f32x4 q = oacc[et] * oacc[et]; ss += (q[0] + q[1]) + (q[2] + q[3]); }
            ss += __shfl_xor(ss, 16); ss += __shfl_xor(ss, 32);
            const float rs = __builtin_amdgcn_rsqf(ss * (1.0f / 128.0f) + EPS);
            if (valid) {
#pragma unroll
                for (int et = 0; et < 8; ++et) { const f32x4 g4 = *(const f32x4*)(og + 16 * et + 4 * q4);
                    const float g0 = bflo(graw[et][0]), g1 = bfhi(graw[et][0]), g2 = bflo(graw[et][1]), g3 = bfhi(graw[et][1]);
                    const float y0 = oacc[et][0] * rs * g4[0] * (g0 * __builtin_amdgcn_rcpf(1.0f + __expf(-g0))), y1 = oacc[et][1] * rs * g4[1] * (g1 * __builtin_amdgcn_rcpf(1.0f + __expf(-g1)));
                    const float y2 = oacc[et][2] * rs * g4[2] * (g2 * __builtin_amdgcn_rcpf(1.0f + __expf(-g2))), y3 = oacc[et][3] * rs * g4[3] * (g3 * __builtin_amdgcn_rcpf(1.0f + __expf(-g3)));
                    *(GAS u32x2*)(O + row * DM + h * 128 + 16 * et + 4 * q4) = (u32x2){pk2(y0, y1), pk2(y2, y3)}; } }
        }
        HG_BAR();
    }
#undef HG_ROW
#undef HG_LOAD
}
#undef HG_BAR
}
namespace sk {
typedef short bf16x8 __attribute__((ext_vector_type(8)));
__device__ __forceinline__ float red32(float v) {
#pragma unroll
    for (int m = 1; m < 32; m <<= 1) v += __shfl_xor(v, m);
    return v; }
__device__ __forceinline__ float red16(float v) {
#pragma unroll
    for (int m = 1; m < 16; m <<= 1) v += __shfl_xor(v, m);
    return v; }
struct SkIn {
    bf16* P; const float* ssq; const float* gq; const float* gk; float qscale; const float* lb;
    static constexpr int NT = 4;
    __device__ __forceinline__ int slot(int u, int ct) const { return (u >> 2) * 256 + (ct >> 1) * 128 + 32 * (u & 3) + (ct & 1) * 16; }
    __device__ __forceinline__ void operator()(int u, int row, int c0, float v0, float v1) const {
        const float rs = __builtin_amdgcn_rsqf(ssq[MR + row] * (1.0f / DM) + EPS); v0 *= rs; v1 *= rs;
        if (u >= 128 && u < 192) { const float r2 = __builtin_amdgcn_rsqf(red32(v0 * v0 + v1 * v1) * (1.0f / 64.0f) + EPS);
            const float* g = (u < 160 ? gq : gk) + (u & 1) * 64 + c0; const float sc = u < 160 ? qscale : 1.f; v0 *= r2 * g[0] * sc; v1 *= r2 * g[1] * sc; }
        if (u >= 32 && u < 64) { const float* l2 = lb + 64 * (u - 32) + c0;
            v0 = fmaxf(__logf(l2[0] + (1.0f - l2[0]) * __builtin_amdgcn_rcpf(1.0f + __expf(-v0))), -60.0f); v1 = fmaxf(__logf(l2[1] + (1.0f - l2[1]) * __builtin_amdgcn_rcpf(1.0f + __expf(-v1))), -60.0f); }
        *(GAS unsigned*)(P + (size_t)(MR + row) * INC + 64 * u + c0) = pk2(v0, v1);
    }
};
struct SkUp {
    bf16* Z; const float* ssq;
    static constexpr int NT = 4;
    __device__ __forceinline__ int slot(int u, int ct) const { return (u >> 2) * 256 + (ct >> 1) * 128 + 32 * (u & 3) + (ct & 1) * 16; }
    __device__ __forceinline__ void operator()(int u, int row, int c0, float v0, float v1) const {
        const float rs = __builtin_amdgcn_rsqf(ssq[MR + row] * (1.0f / DM) + EPS); v0 = fmaxf(v0 * rs, 0.f); v1 = fmaxf(v1 * rs, 0.f);
        *(GAS unsigned*)(Z + (size_t)(MR + row) * FF + 64 * u + c0) = pk2(v0 * v0, v1 * v1);
    }
};
struct SkRes {
    const float* basef; bf16* HB; float* ssq;
    static constexpr int NT = 1;
    __device__ __forceinline__ int slot(int u, int ct) const { const int c = 16 * u, cc = c & 255; return (c & ~255) + 128 * ((cc >> 5) & 1) + 32 * (cc >> 6) + (cc & 31); }
    __device__ __forceinline__ void operator()(int u, int row, int c0, float v0, float) const {
        const int col = 16 * u + c0; const size_t o = (size_t)(MR + row) * DM + col;
        const float hv = (basef ? basef[(size_t)row * DM + col] : bf2f(HB[o])) + v0;
        HB[o] = (bf16)f2bf(hv);
        const float ss = red16(hv * hv); if (c0 == 0) atomicAdd(ssq + MR + row, ss);
    }
};
template <class Epi> __device__ __forceinline__ void skinny_phase(Frame& F, const bf16* A, const bf16* Bt, int N, int K, const Epi& E) {
    constexpr int NT = Epi::NT, CPT = (NT == 4) ? 2 : 1, TPR = 16 * NT / CPT;
    int tid_ = threadIdx.x; asm volatile("" : "+v"(tid_));
    const int tid = tid_, lane = tid & 63, wid = __builtin_amdgcn_readfirstlane(tid >> 6), c15 = lane & 15, q4 = lane >> 4;
    LAS float* red = (LAS float*)(F.lds + RING_OFF);
    const int units = N / (16 * NT), kw = K / 8, nks = kw / 32;
    for (int u = F.vcu; u < units; u += F.G) {
        f32x4 acc[NT];
#pragma unroll
        for (int ct = 0; ct < NT; ++ct) acc[ct] = (f32x4){0.f, 0.f, 0.f, 0.f};
        const bf16* ap = A + (size_t)c15 * K + wid * kw + 8 * q4;
        const bf16* bp[NT];
#pragma unroll
        for (int ct = 0; ct < NT; ++ct) bp[ct] = Bt + (size_t)(E.slot(u, ct) + c15) * K + wid * kw + 8 * q4;
#pragma unroll 4
        for (int ks = 0; ks < nks; ++ks) { const bf16x8 a = *(const GAS bf16x8*)(ap + 32 * ks);
#pragma unroll
            for (int ct = 0; ct < NT; ++ct) acc[ct] = __builtin_amdgcn_mfma_f32_16x16x32_bf16(*(const GAS bf16x8*)(bp[ct] + 32 * ks), a, acc[ct], 0, 0, 0); }
#pragma unroll
        for (int ct = 0; ct < NT; ++ct) *(LAS f32x4*)(red + (wid * 16 + c15) * (16 * NT) + 16 * ct + 4 * q4) = acc[ct];
        asm volatile("s_waitcnt lgkmcnt(0)" ::: "memory"); __builtin_amdgcn_s_barrier(); asm volatile("" ::: "memory");
        if (tid < 16 * TPR) { const int row = tid / TPR, c0 = (tid % TPR) * CPT; float v0 = 0.f, v1 = 0.f;
#pragma unroll
            for (int w = 0; w < 8; ++w) { v0 += red[(w * 16 + row) * (16 * NT) + c0]; if (CPT == 2) v1 += red[(w * 16 + row) * (16 * NT) + c0 + 1]; }
            E(u, row, c0, v0, v1); }
        asm volatile("s_waitcnt lgkmcnt(0)" ::: "memory"); __builtin_amdgcn_s_barrier(); asm volatile("" ::: "memory");
    }
}
}

struct Args { const float* in[14]; float* out; unsigned char* ws; int ph_lo, ph_hi, li, pad; };
constexpr int PH_PER_LAYER = 5, N_PHASES = 1 + DEPTH * PH_PER_LAYER;

constexpr int CU_IN = (DM / 512) * (INC / 64), CU_OUT = (DM / 512) * (DM / 64), CU_UP = (DM / 512) * (FF / 64), CU_DN = (FF / 512) * (DM / 64);
__device__ __forceinline__ void conv_mat(const Args& args, int mat, int l, int unit, int lane, LAS unsigned char* tile) {
    unsigned char* ws = args.ws;
    if (mat == 0) p0_convert_unit(args.in[3] + (size_t)l * DM * INC, DM, INC, (bf16*)(ws + WS_WIN) + (size_t)l * INC * DM, args.in[2] + l * DM, 0, INC, unit, lane, tile);
    else if (mat == 1) p0_convert_unit(args.in[10] + (size_t)l * DM * DM, DM, DM, (bf16*)(ws + WS_WOUT) + (size_t)l * DM * DM, nullptr, 0, DM, unit, lane, tile);
    else if (mat == 2) p0_convert_unit(args.in[12] + (size_t)l * DM * FF, DM, FF, (bf16*)(ws + WS_WUP) + (size_t)l * FF * DM, args.in[11] + l * DM, 0, FF, unit, lane, tile);
    else p0_convert_unit(args.in[13] + (size_t)l * FF * DM, FF, DM, (bf16*)(ws + WS_WDN) + (size_t)l * DM * FF, nullptr, 0, DM, unit, lane, tile);
}
constexpr int CV_N0 = CU_OUT + CU_UP + CU_DN + CU_IN, CV_N1 = CU_OUT + CU_UP + CU_DN;
__device__ __forceinline__ void conv_phase_unit(const Args& args, int layer, int wu, int lane, LAS unsigned char* tile) {
    if (wu >= (layer == 0 ? CV_N0 : CV_N1)) return;
    if (wu < CU_OUT) { conv_mat(args, 1, layer, wu, lane, tile); return; } wu -= CU_OUT;
    if (wu < CU_UP) { conv_mat(args, 2, layer, wu, lane, tile); return; } wu -= CU_UP;
    if (wu < CU_DN) { conv_mat(args, 3, layer, wu, lane, tile); return; } wu -= CU_DN;
    conv_mat(args, 0, 1, wu, lane, tile);
}
__device__ __forceinline__ void p0_prologue(Frame& F, const Args& args) {
    int tid_ = threadIdx.x; asm volatile("" : "+v"(tid_)); const int lane = tid_ & 63, wave = __builtin_amdgcn_readfirstlane(tid_ >> 6);
    const int gw = F.vcu * NWAVES + wave, NGW = F.G * NWAVES;
    unsigned char* ws = args.ws;
    for (int it = gw; it < CU_IN; it += NGW) conv_mat(args, 0, 0, it, lane, F.lds + RING_OFF + wave * CV_LDS_WAVE);
    if (gw < AW / 64) { const int c = gw * 64 + lane; ((float*)(ws + WS_LB))[AW + c] = 1.0f / (1.0f + __expf(args.in[4][c] - args.in[4][AW + c])); }
    bf16* HB = (bf16*)(ws + WS_HB); float* ssq0 = (float*)(ws + WS_SSQ);
    for (int m = gw; m < MROWS; m += NGW) row_to_bf16_ssq(m < MR ? args.in[0] + (size_t)m * DM : args.in[1] + (size_t)(m - MR) * DM, HB + (size_t)m * DM, ssq0 + m, lane);
}

__device__ __forceinline__ int mx_bh(int x, int k) { const int b = k & 3, hi = (k < 4); const int h = (b < 2) ? (hi ? 15 - x : x) : (hi ? 8 + x : 7 - x); return b * 16 + h; }
__device__ __forceinline__ int mx_grab(gu32* head, volatile LAS unsigned* slot) {
    asm volatile("s_waitcnt lgkmcnt(0)" ::: "memory"); __builtin_amdgcn_s_barrier(); asm volatile("" ::: "memory");
    if (threadIdx.x == 0) *slot = __hip_atomic_fetch_add(head, 1u, RLX_AGENT);
    asm volatile("s_waitcnt vmcnt(0) lgkmcnt(0)" ::: "memory"); __builtin_amdgcn_s_barrier(); asm volatile("" ::: "memory");
    return (int)*slot;
}
__device__ __forceinline__ void mixer_phase(Frame& F, const Args& args, const bf16* P, bf16* O, const float* lbraw, const float* hog, const float* lp, const float* aog, const float* qg, const float* kg, int layer, int rep, int kinds) {
    int tid_ = threadIdx.x; asm volatile("" : "+v"(tid_));
    const float lam_init = 0.8f - 0.6f * __expf(-0.3f * (float)layer);
    float lam; { const int lane = tid_ & 63; const float a = wave_sum(lp[lane] * lp[64 + lane]), cc = wave_sum(lp[128 + lane] * lp[192 + lane]); lam = __expf(a) - __expf(cc) + lam_init; }
    float skipnum; { const int lane = tid_ & 63;
        const float a = wave_max(fmaxf(fabsf(qg[lane]), fabsf(qg[64 + lane]))), bq = wave_max(fmaxf(fabsf(kg[lane]), fabsf(kg[64 + lane])));
        skipnum = 2.0f * (8.0f * a * bq * LOG2E * 1.02f) + 66.0f; }
    const int x0 = (int)(xb_xcc_id() & 7u);
    gu32* qc = F.ctl + CW_Q + ((rep * DEPTH + layer) * 2 + 0) * 512; gu32* qa = F.ctl + CW_Q + ((rep * DEPTH + layer) * 2 + 1) * 512;
    if (kinds & 1) for (int k = 0; k < 8; ++k) { const int qx = (x0 + k) & 7;
        for (;;) { const int i = mx_grab(qc + qx * 64, F.MISC + 16); if (i >= 8) break; const int bh = mx_bh(qx, i);
            hg::hgrn_chain(P, O, lbraw, hog, layer, bh >> 4, bh & 15, F.lds); } }
    gu32* qv = F.ctl + CW_Q + (2 * DEPTH * 2 + layer) * 512; const int ncv = ((layer == 0 ? CV_N0 : CV_N1) + 7) / 8; const int wave = __builtin_amdgcn_readfirstlane(tid_ >> 6);
    int adone = 0, cdone = 0; bool cv_left = (rep == 0);
    if (kinds & 2) for (int k = 0; k < 8; ++k) { const int qx = (x0 + k) & 7;
        for (;;) { const int i = mx_grab(qa + qx * 64, F.MISC + 16); if (i >= 256) break; const int bh = mx_bh(qx, i >> 5), qb = 31 - (i & 31);
            fa::attn_unit(P, O, bh >> 4, bh & 15, qb, lam, lam_init, skipnum, aog, F.lds + RING_OFF); ++adone;
            while (cv_left && cdone * 2048 < adone * ncv * 2) { const int ci = mx_grab(qv, F.MISC + 16); if (ci >= ncv) { cv_left = false; break; } conv_phase_unit(args, layer, ci * 8 + wave, tid_ & 63, F.lds + RING_OFF + wave * CV_LDS_WAVE); ++cdone; } } }
    while (cv_left) { const int ci = mx_grab(qv, F.MISC + 16); if (ci >= ncv) break; conv_phase_unit(args, layer, ci * 8 + wave, tid_ & 63, F.lds + RING_OFF + wave * CV_LDS_WAVE); }
}


__global__ void __launch_bounds__(NWAVES * 64, 2) fwd(Args args) {
    extern __shared__ __attribute__((aligned(16))) unsigned char lds[];
    Frame F;
    F.lds = (LAS unsigned char*)lds;
    F.MISC = (volatile LAS unsigned*)(F.lds + MISC_OFF);
    F.tid = threadIdx.x; F.lane = F.tid & 63; F.wave = __builtin_amdgcn_readfirstlane(F.tid >> 6);
    F.G = gridDim.x; { const int bx = blockIdx.x; F.vcu = (F.G % 8 == 0) ? (bx % 8) * (F.G / 8) + bx / 8 : bx; }
    unsigned char* ws = args.ws;
    F.ctl = (gu32*)(ws + WS_CTL);
    for (int u = F.tid; u < (LDS_BYTES - LDSCTL_OFF) / 4; u += NWAVES * 64) ((LAS unsigned*)(F.lds + LDSCTL_OFF))[u] = 0u;
    __syncthreads();
    XcdBarrier bar = xcd_barrier_post((unsigned*)(F.ctl + CW_BAR) + args.li * XCD_BAR_WORDS, F.MISC + 8);
    const int lo = args.ph_lo, hi = args.ph_hi;
#define IN(k) (lo <= (k) && (k) < hi)
#define SEAM(k) do { if (IN(k) && IN((k) + 1)) xcd_barrier(bar); } while (0)
    bf16* WIN = (bf16*)(ws + WS_WIN); bf16* WOUT = (bf16*)(ws + WS_WOUT); bf16* WUP = (bf16*)(ws + WS_WUP); bf16* WDN = (bf16*)(ws + WS_WDN);
    bf16* HB = (bf16*)(ws + WS_HB); bf16* OB = (bf16*)(ws + WS_O); bf16* PZ = (bf16*)(ws + WS_PZ);

    if (IN(0)) p0_prologue(F, args);
    SEAM(0);

    for (int l = 0; l < DEPTH; ++l) {
        const int pb = 1 + l * PH_PER_LAYER;
        float* ssqA = (float*)(ws + WS_SSQ + (size_t)(2 * l) * SSQ_STRIDE); float* ssqB = (float*)(ws + WS_SSQ + (size_t)(2 * l + 1) * SSQ_STRIDE); float* ssqC = (float*)(ws + WS_SSQ + (size_t)(2 * l + 2) * SSQ_STRIDE);
        if (IN(pb + 0)) {
            pg8::Gemm g{HB, WIN + (size_t)l * INC * DM, MR, INC, DM}; pg8::StaticOrder S; S.init(MR, INC, F.G, (int)blockIdx.x);
            pg8::EpiIn E{PZ, INC, ssqA, args.in[6] + l * 128, args.in[7] + l * 128, QSCALE, (const float*)(ws + WS_LB) + l * AW};
            pg8::gemm_phase<pg8::EpiIn, pg8::StaticOrder, true, true>(F.lds + RING_OFF, g, S, E);
            sk::SkIn SE{PZ, ssqA, args.in[6] + l * 128, args.in[7] + l * 128, QSCALE, (const float*)(ws + WS_LB) + l * AW};
            sk::skinny_phase(F, HB + (size_t)MR * DM, WIN + (size_t)l * INC * DM, INC, DM, SE);
        }
        SEAM(pb + 0);
        if (IN(pb + 1)) {
            mixer_phase(F, args, PZ, OB, args.in[4], args.in[5] + l * 128, args.in[8] + l * 256, args.in[9] + l * 128, args.in[6] + l * 128, args.in[7] + l * 128, l, 0, 3);
            __syncthreads();
            attn_ref(F, PZ, OB, args.in[8] + l * 256, args.in[9] + l * 128, l, MR * 16, MROWS * 16);
        }
        SEAM(pb + 1);
        if (IN(pb + 2)) {
            pg8::Gemm g{OB, WOUT + (size_t)l * DM * DM, MR, DM, DM}; pg8::StaticOrder S; S.init(MR, DM, F.G, (int)blockIdx.x);
            pg8::EpiRes E{nullptr, HB, nullptr, ssqB};
            pg8::gemm_phase<pg8::EpiRes, pg8::StaticOrder, true, true>(F.lds + RING_OFF, g, S, E);
            sk::SkRes SE{nullptr, HB, ssqB};
            sk::skinny_phase(F, OB + (size_t)MR * DM, WOUT + (size_t)l * DM * DM, DM, DM, SE);
        }
        SEAM(pb + 2);
        if (IN(pb + 3)) {
            pg8::Gemm g{HB, WUP + (size_t)l * FF * DM, MR, FF, DM}; pg8::StaticOrder S; S.init(MR, FF, F.G, (int)blockIdx.x);
            pg8::EpiUp E{PZ, FF, ssqB};
            pg8::gemm_phase<pg8::EpiUp, pg8::StaticOrder, true, true>(F.lds + RING_OFF, g, S, E);
            sk::SkUp SE{PZ, ssqB};
            sk::skinny_phase(F, HB + (size_t)MR * DM, WUP + (size_t)l * FF * DM, FF, DM, SE);
        }
        SEAM(pb + 3);
        if (IN(pb + 4)) {
            const bool last = (l == DEPTH - 1);
            pg8::Gemm g{PZ, WDN + (size_t)l * DM * FF, MR, DM, FF}; pg8::StaticOrder S; S.init(MR, DM, F.G, (int)blockIdx.x);
            pg8::EpiRes E{nullptr, HB, last ? args.out : nullptr, ssqC};
            pg8::gemm_phase<pg8::EpiRes, pg8::StaticOrder, true, true>(F.lds + RING_OFF, g, S, E);
            if (!last) { sk::SkRes SE{nullptr, HB, ssqC};
                sk::skinny_phase(F, PZ + (size_t)MR * FF, WDN + (size_t)l * DM * FF, DM, FF, SE); }
        }
        SEAM(pb + 4);
    }
#undef IN
#undef SEAM
}

#ifndef MK_CUTS
#define MK_CUTS 0
#endif
extern "C" void kernel_launch(void* const* d_in, const int* in_sizes, int n_in, void* d_out, int out_size, void* d_ws, size_t ws_size, hipStream_t stream) {
    static int grid = 0;
    if (grid == 0) {
        if (n_in != 14 || in_sizes[0] != MR * DM || out_size != MR * DM || ws_size < WS_END) { fprintf(stderr, "kernel_launch: unexpected shapes / workspace (%d inputs, ws %zu < %zu)\n", n_in, ws_size, (size_t)WS_END); grid = -1; return; }
        int dev = 0, cus = 0, per_cu = 0;
        if (hipGetDevice(&dev) != hipSuccess || hipDeviceGetAttribute(&cus, hipDeviceAttributeMultiprocessorCount, dev) != hipSuccess) { grid = -1; return; }
        if (hipFuncSetAttribute((const void*)fwd, hipFuncAttributeMaxDynamicSharedMemorySize, LDS_BYTES) != hipSuccess) { fprintf(stderr, "kernel_launch: hipFuncSetAttribute failed\n"); grid = -1; return; }
        if (hipOccupancyMaxActiveBlocksPerMultiprocessor(&per_cu, (const void*)fwd, NWAVES * 64, LDS_BYTES) != hipSuccess || per_cu < 1) { fprintf(stderr, "kernel_launch: occupancy query says %d\n", per_cu); }
        (void)hipGetLastError();
        grid = cus;
    }
    if (grid < 0) return;
    if (hipMemsetAsync((char*)d_ws + WS_CTL, 0, CTL_ZERO_BYTES, stream) != hipSuccess) return;
    Args a{};
    for (int i = 0; i < 14; ++i) a.in[i] = (const float*)d_in[i];
    a.out = (float*)d_out; a.ws = (unsigned char*)d_ws;
#if MK_CUTS == 0
    a.ph_lo = 0; a.ph_hi = N_PHASES; a.li = 0; a.pad = 0;
    hipLaunchKernelGGL(fwd, dim3(grid), dim3(NWAVES * 64), LDS_BYTES, stream, a);
#else
    for (int p = 0; p < N_PHASES; ++p) { a.ph_lo = p; a.ph_hi = p + 1; a.li = p; a.pad = 0; hipLaunchKernelGGL(fwd, dim3(grid), dim3(NWAVES * 64), LDS_BYTES, stream, a); }
#endif
}
```

```cpp
#include <hip/hip_runtime.h>
#include <cstdio>
#include <cstdint>
namespace pg8 {
#define PG8_LAS __attribute__((address_space(3)))
typedef unsigned short bf16_t;
typedef short bf16x8 __attribute__((ext_vector_type(8)));
typedef float f32x4 __attribute__((ext_vector_type(4)));
typedef unsigned u32x4 __attribute__((ext_vector_type(4)));
constexpr int BM = 256, BK = 64, HALF = 128, HTB = HALF * BK * 2  , STAGE_BYTES = 8 * HTB, NXCD = 8, WGM = 8;

__host__ __device__ __forceinline__ int lds_byte(int r, int c) { const int st = (r >> 4) * 2 + (c >> 5), rr = r & 15, cc = c & 31, ob = rr * 64 + cc * 2; return st * 1024 + (ob ^ (((ob >> 9) & 1) << 5)); }
__host__ __device__ __forceinline__ void stage_rc(int b, int& R, int& C) { const int st = b / 1024, sb = b % 1024, swz = sb ^ (((sb >> 9) & 1) << 5); R = (st >> 1) * 16 + swz / 64; C = (st & 1) * 32 + (swz % 64) / 2; }
__host__ __device__ __forceinline__ int perm32(int rho) { const int n = rho >> 4, i = rho & 15; return 8 * (i >> 2) + 4 * n + (i & 3); }

struct Unit { int pm, pn; };
struct Gemm { const bf16_t* A; const bf16_t* Bt; int M, N, K; };

struct StaticOrder {
    int nM, nN, nwg, G, c, wgm;
    __host__ __device__ void init(int M, int N, int G_, int c_, int wgm_ = WGM) { nM = M / BM; nN = N / BM; nwg = nM * nN; G = G_; c = c_; wgm = wgm_; }
    __host__ __device__ bool next(int i, Unit& u) const {
        const long L = (long)i * G + c; if (L >= nwg) return false;
        int wgid = (int)L; { const int q = nwg / NXCD, r = nwg % NXCD, xcd = wgid % NXCD, off = wgid / NXCD; wgid = (xcd < r ? xcd * (q + 1) : r * (q + 1) + (xcd - r) * q) + off; }
        const int nig = wgm * nN, gid = wgid / nig, fm = gid * wgm, gsz = (nM - fm) < wgm ? (nM - fm) : wgm;
        u.pm = fm + ((wgid % nig) % gsz); u.pn = (wgid % nig) / gsz; return true;
    }
    __device__ __forceinline__ void a_ready(const Unit&) const {}
    __device__ __forceinline__ void done(const Unit&) const {}
};

__device__ __forceinline__ unsigned cvt_pk_bf16(float lo, float hi) { unsigned r; asm volatile("v_cvt_pk_bf16_f32 %0, %1, %2" : "=v"(r) : "v"(lo), "v"(hi)); return r; }
typedef float f32x2 __attribute__((ext_vector_type(2)));
constexpr int E_D = 4096, E_MR = 16384, E_MROWS = 16400;
constexpr float E_EPS = 1e-6f;
__device__ __forceinline__ u32x4 pack8(const f32x4 a, const f32x4 b) { u32x4 w; w.x = cvt_pk_bf16(a[0], a[1]); w.y = cvt_pk_bf16(a[2], a[3]); w.z = cvt_pk_bf16(b[0], b[1]); w.w = cvt_pk_bf16(b[2], b[3]); return w; }
struct EpiIn {
    static constexpr bool PERM = true, AFTER_DRAIN = false;
    bf16_t* P; int ldp; const float* ssq; const float* gq; const float* gk; float qscale; const float* lb;
    __device__ __forceinline__ void pre(const Unit& u, int wr, int fr, float (&aux)[8]) const {
#pragma unroll
        for (int k = 0; k < 8; ++k) aux[k] = ssq[u.pm * BM + wr * 64 + fr + (k >> 2) * HALF + (k & 3) * 16]; }
    __device__ __forceinline__ void operator()(const f32x4 (&acc)[2][2][4][2], const Unit& u, int wr, int wc, int fr, int fq, const float (&aux)[8]) const {
        const int row0 = u.pm * BM + wr * 64 + fr;
        const int sect = u.pn >> 3;
        if (sect == 4 || sect == 5) {
            const float* g = (sect == 4 ? gq : gk) + (wc & 1) * 64; const float sc = sect == 4 ? qscale : 1.f;
            f32x4 gv[2][2];
#pragma unroll
            for (int bj = 0; bj < 2; ++bj)
#pragma unroll
                for (int n = 0; n < 2; ++n) gv[bj][n] = *(const f32x4*)(g + 32 * bj + 8 * fq + 4 * n) * sc;
#pragma unroll
            for (int ai = 0; ai < 2; ++ai)
#pragma unroll
                for (int m = 0; m < 4; ++m) { const int row = row0 + ai * HALF + m * 16;
                    const float rs = __builtin_amdgcn_rsqf(aux[ai * 4 + m] * (1.0f / E_D) + E_EPS);
                    f32x4 v[2][2]; float ss = 0.f;
#pragma unroll
                    for (int bj = 0; bj < 2; ++bj)
#pragma unroll
                        for (int n = 0; n < 2; ++n) { v[bj][n] = acc[ai][bj][m][n] * rs; const f32x4 q = v[bj][n] * v[bj][n]; ss += (q[0] + q[1]) + (q[2] + q[3]); }
                    ss += __shfl_xor(ss, 16); ss += __shfl_xor(ss, 32);
                    const float r2 = __builtin_amdgcn_rsqf(ss * (1.0f / 64.0f) + E_EPS);
                    bf16_t* rowp = P + (size_t)row * ldp + u.pn * BM + 64 * wc + 8 * fq;
#pragma unroll
                    for (int bj = 0; bj < 2; ++bj) *(u32x4*)(rowp + 32 * bj) = pack8(v[bj][0] * r2 * gv[bj][0], v[bj][1] * r2 * gv[bj][1]); }
        } else if (sect == 1) {
            f32x4 lbv[2][2];
#pragma unroll
            for (int bj = 0; bj < 2; ++bj)
#pragma unroll
                for (int n = 0; n < 2; ++n) lbv[bj][n] = *(const f32x4*)(lb + (u.pn - 8) * BM + 64 * wc + 32 * bj + 8 * fq + 4 * n);
#pragma unroll
            for (int ai = 0; ai < 2; ++ai)
#pragma unroll
                for (int m = 0; m < 4; ++m) { const int row = row0 + ai * HALF + m * 16;
                    const float rs = __builtin_amdgcn_rsqf(aux[ai * 4 + m] * (1.0f / E_D) + E_EPS);
                    bf16_t* rowp = P + (size_t)row * ldp + u.pn * BM + 64 * wc + 8 * fq;
#pragma unroll
                    for (int bj = 0; bj < 2; ++bj) { f32x4 o[2];
#pragma unroll
                        for (int n = 0; n < 2; ++n)
#pragma unroll
                            for (int i = 0; i < 4; ++i) { const float x = acc[ai][bj][m][n][i] * rs, sg = __builtin_amdgcn_rcpf(1.0f + __expf(-x)), l0 = lbv[bj][n][i]; o[n][i] = fmaxf(__logf(l0 + (1.0f - l0) * sg), -60.0f); }
                        *(u32x4*)(rowp + 32 * bj) = pack8(o[0], o[1]); } }
        } else {
#pragma unroll
            for (int ai = 0; ai < 2; ++ai)
#pragma unroll
                for (int m = 0; m < 4; ++m) { const int row = row0 + ai * HALF + m * 16;
                    const float rs = __builtin_amdgcn_rsqf(aux[ai * 4 + m] * (1.0f / E_D) + E_EPS);
                    bf16_t* rowp = P + (size_t)row * ldp + u.pn * BM + 64 * wc + 8 * fq;
#pragma unroll
                    for (int bj = 0; bj < 2; ++bj) *(u32x4*)(rowp + 32 * bj) = pack8(acc[ai][bj][m][0] * rs, acc[ai][bj][m][1] * rs); }
        }
    }
};
struct EpiUp {
    static constexpr bool PERM = true, AFTER_DRAIN = false;
    bf16_t* Z; int ldz; const float* ssq;
    __device__ __forceinline__ void pre(const Unit& u, int wr, int fr, float (&aux)[8]) const {
#pragma unroll
        for (int k = 0; k < 8; ++k) aux[k] = ssq[u.pm * BM + wr * 64 + fr + (k >> 2) * HALF + (k & 3) * 16]; }
    __device__ __forceinline__ void operator()(const f32x4 (&acc)[2][2][4][2], const Unit& u, int wr, int wc, int fr, int fq, const float (&aux)[8]) const {
        const int row0 = u.pm * BM + wr * 64 + fr;
#pragma unroll
        for (int ai = 0; ai < 2; ++ai)
#pragma unroll
            for (int m = 0; m < 4; ++m) { const int row = row0 + ai * HALF + m * 16;
                const float rs = __builtin_amdgcn_rsqf(aux[ai * 4 + m] * (1.0f / E_D) + E_EPS);
                bf16_t* rowp = Z + (size_t)row * ldz + u.pn * BM + 64 * wc + 8 * fq;
#pragma unroll
                for (int bj = 0; bj < 2; ++bj) { f32x4 a = acc[ai][bj][m][0] * rs, b = acc[ai][bj][m][1] * rs;
                    a = __builtin_elementwise_max(a, (f32x4){0.f, 0.f, 0.f, 0.f}); b = __builtin_elementwise_max(b, (f32x4){0.f, 0.f, 0.f, 0.f});
                    *(u32x4*)(rowp + 32 * bj) = pack8(a * a, b * b); } }
    }
};
struct EpiRes {
    static constexpr bool PERM = true, AFTER_DRAIN = false;
    const float* basef; bf16_t* hb; float* outf; float* ssq;
    __device__ __forceinline__ void pre(const Unit&, int, int, float (&)[8]) const {}
    __device__ __forceinline__ void operator()(const f32x4 (&acc)[2][2][4][2], const Unit& u, int wr, int wc, int fr, int fq, const float (&)[8]) const {
        const int row0 = u.pm * BM + wr * 64 + fr; const int col0 = u.pn * BM + 64 * wc + 8 * fq;
#pragma unroll
        for (int ai = 0; ai < 2; ++ai)
#pragma unroll
            for (int m = 0; m < 4; ++m) { const size_t off = (size_t)(row0 + ai * HALF + m * 16) * E_D + col0;
                float part = 0.f;
#pragma unroll
                for (int bj = 0; bj < 2; ++bj) { f32x4 a, b;
                    if (basef) { a = *(const f32x4*)(basef + off + 32 * bj); b = *(const f32x4*)(basef + off + 32 * bj + 4); }
                    else { const u32x4 r = *(const u32x4*)(hb + off + 32 * bj);
                        a = (f32x4){__uint_as_float(r.x << 16), __uint_as_float(r.x & 0xffff0000u), __uint_as_float(r.y << 16), __uint_as_float(r.y & 0xffff0000u)};
                        b = (f32x4){__uint_as_float(r.z << 16), __uint_as_float(r.z & 0xffff0000u), __uint_as_float(r.w << 16), __uint_as_float(r.w & 0xffff0000u)}; }
                    a += acc[ai][bj][m][0]; b += acc[ai][bj][m][1];
                    if (outf) { *(f32x4*)(outf + off + 32 * bj) = a; *(f32x4*)(outf + off + 32 * bj + 4) = b; }
                    else { *(u32x4*)(hb + off + 32 * bj) = pack8(a, b);
                        const f32x4 qa = a * a, qb = b * b; part += ((qa[0] + qa[1]) + (qa[2] + qa[3])) + ((qb[0] + qb[1]) + (qb[2] + qb[3])); } }
                if (!outf) { part += __shfl_xor(part, 16); part += __shfl_xor(part, 32); if (fq == 0) atomicAdd(ssq + row0 + ai * HALF + m * 16, part); }
                if (m == 3) asm volatile("" ::: "memory"); }
    }
};
template <class Epi, class Sched, bool ALIGN_EPI = false, bool SP2 = false>
__device__ __forceinline__ void gemm_phase(PG8_LAS unsigned char* lds, const Gemm g, const Sched& S, const Epi& E) {
    int tid_ = threadIdx.x; asm volatile("" : "+v"(tid_));
    const int tid = tid_, wid = __builtin_amdgcn_readfirstlane(tid >> 6), lane = tid & 63, wr = wid >> 2, wc = wid & 3, fr = lane & 15, fq = lane >> 4;
    const int K = g.K, nt = K / BK;
    unsigned voffA[2], voffB[2];
#pragma unroll
    for (int i = 0; i < 2; ++i) { int R, C; stage_rc(tid * 16 + i * 8192, R, C); const int Rb = Epi::PERM ? ((R & ~31) + perm32(R & 31)) : R;
        voffA[i] = (unsigned)(R * K + C) * 2u; voffB[i] = (unsigned)(Rb * K + C) * 2u; }
    const size_t kstep = (size_t)(BK * 2);
    const size_t hstep = (size_t)HALF * K * 2;
    const size_t tstep = 2 * hstep;
    const unsigned ldsw = (unsigned)wid * 1024u;
    const int aoff = lds_byte(wr * 64 + fr, fq * 8), boff = lds_byte(wc * 32 + fr, fq * 8);
#define PG8_SA(b, h) (((b) * 2 + (h)) * HTB)
#define PG8_SB(b, h) ((4 + (b) * 2 + (h)) * HTB)
#define PG8_STAGE(bufoff, gbase, voff) do { _Pragma("unroll") for (int _i = 0; _i < 2; ++_i) \
        __builtin_amdgcn_global_load_lds((const unsigned*)((const char*)(gbase) + (voff)[_i]), (PG8_LAS unsigned*)(lds + (bufoff) + ldsw + _i * 8192), 16, 0, 0); } while (0)
#define PG8_LDA(dst, b, h) do { _Pragma("unroll") for (int m = 0; m < 4; ++m) _Pragma("unroll") for (int k = 0; k < 2; ++k) dst[m][k] = *(const PG8_LAS bf16x8*)(lds + PG8_SA(b, h) + aoff + m * 2048 + k * 1024); } while (0)
#define PG8_LDB(dst, b, h) do { _Pragma("unroll") for (int n = 0; n < 2; ++n) _Pragma("unroll") for (int k = 0; k < 2; ++k) dst[n][k] = *(const PG8_LAS bf16x8*)(lds + PG8_SB(b, h) + boff + n * 2048 + k * 1024); } while (0)
#define PG8_MMA(ai, bj, At, Bt) do { __builtin_amdgcn_s_setprio(1); _Pragma("unroll") for (int m = 0; m < 4; ++m) _Pragma("unroll") for (int n = 0; n < 2; ++n) _Pragma("unroll") for (int k = 0; k < 2; ++k) \
        acc[ai][bj][m][n] = __builtin_amdgcn_mfma_f32_16x16x32_bf16(Bt[n][k], At[m][k], acc[ai][bj][m][n], 0, 0, 0); __builtin_amdgcn_s_setprio(0); } while (0)
#define PG8_WAIT_V(n) asm volatile("s_waitcnt vmcnt(" #n ")" ::: "memory")
#define PG8_WAIT_L(n) asm volatile("s_waitcnt lgkmcnt(" #n ")" ::: "memory")
#define PG8_BAR __builtin_amdgcn_s_barrier()
#define PG8_SCHED __builtin_amdgcn_sched_barrier(0)
    Unit cur, nxt; int ui = 0;
    if (!S.next(0, cur)) return;
    f32x4 acc[2][2][4][2];
#pragma unroll
    for (int a = 0; a < 2; ++a)
#pragma unroll
        for (int b = 0; b < 2; ++b)
#pragma unroll
            for (int m = 0; m < 4; ++m)
#pragma unroll
                for (int n = 0; n < 2; ++n) acc[a][b][m][n] = (f32x4){0.f, 0.f, 0.f, 0.f};
    bf16x8 At[4][2], B0[2][2], B1[2][2];
    const char* cA = (const char*)g.A + (size_t)cur.pm * tstep; const char* cB = (const char*)g.Bt + (size_t)cur.pn * tstep;
    float eaux[8]; E.pre(cur, wr, fr, eaux);
    S.a_ready(cur);
    if constexpr (SP2) {
        PG8_STAGE(PG8_SB(0, 0), cB, voffB); PG8_STAGE(PG8_SB(0, 1), cB + hstep, voffB); PG8_STAGE(PG8_SA(0, 0), cA, voffA); PG8_STAGE(PG8_SA(0, 1), cA + hstep, voffA);
        if (wr == 1) PG8_BAR;
        PG8_WAIT_V(2); PG8_BAR;
        PG8_STAGE(PG8_SB(1, 0), cB + kstep, voffB); PG8_STAGE(PG8_SA(1, 0), cA + kstep, voffA); PG8_STAGE(PG8_SB(1, 1), cB + hstep + kstep, voffB);
        PG8_WAIT_V(6); PG8_BAR;
    } else {
        PG8_STAGE(PG8_SB(0, 0), cB, voffB); PG8_STAGE(PG8_SA(0, 0), cA, voffA); PG8_STAGE(PG8_SB(0, 1), cB + hstep, voffB); PG8_STAGE(PG8_SA(0, 1), cA + hstep, voffA);
        if (wr == 1) PG8_BAR;
        PG8_WAIT_V(4); PG8_BAR;
        PG8_STAGE(PG8_SB(1, 0), cB + kstep, voffB); PG8_STAGE(PG8_SA(1, 0), cA + kstep, voffA); PG8_STAGE(PG8_SB(1, 1), cB + hstep + kstep, voffB);
        PG8_WAIT_V(6); PG8_BAR;
    }
    for (;;) {
        const bool has_next = S.next(ui + 1, nxt);
        const char* nA = has_next ? (const char*)g.A + (size_t)nxt.pm * tstep : cA; const char* nB = has_next ? (const char*)g.Bt + (size_t)nxt.pn * tstep : cB;
        for (int t = 0; t < nt; t += 2) {
            const bool last = (t == nt - 2);
            const char* a1 = cA + (size_t)(t + 1) * kstep;
            const char* a2 = last ? nA : cA + (size_t)(t + 2) * kstep; const char* b2 = last ? nB : cB + (size_t)(t + 2) * kstep;
            const char* a3 = a2 + kstep; const char* b3 = b2 + kstep;
            if (last && has_next) S.a_ready(nxt);
            if constexpr (SP2) {
            PG8_LDB(B0, 0, 0); PG8_LDB(B1, 0, 1); PG8_SCHED; PG8_LDA(At, 0, 0); PG8_STAGE(PG8_SA(1, 1), a1 + hstep, voffA);
            PG8_WAIT_V(8); PG8_WAIT_L(0); PG8_BAR; PG8_MMA(0, 0, At, B0); PG8_MMA(0, 1, At, B1); PG8_BAR; PG8_SCHED;
            PG8_LDA(At, 0, 1); PG8_STAGE(PG8_SB(0, 0), b2, voffB); PG8_STAGE(PG8_SB(0, 1), b2 + hstep, voffB); PG8_STAGE(PG8_SA(0, 0), a2, voffA);
            PG8_WAIT_V(8); PG8_WAIT_L(0); PG8_BAR; PG8_MMA(1, 0, At, B0); PG8_MMA(1, 1, At, B1); PG8_BAR; PG8_SCHED;
            PG8_LDB(B0, 1, 0); PG8_LDB(B1, 1, 1); PG8_SCHED; PG8_LDA(At, 1, 0); PG8_STAGE(PG8_SA(0, 1), a2 + hstep, voffA);
            PG8_WAIT_V(8); PG8_WAIT_L(0); PG8_BAR; PG8_MMA(0, 0, At, B0); PG8_MMA(0, 1, At, B1); PG8_BAR; PG8_SCHED;
            PG8_LDA(At, 1, 1); PG8_STAGE(PG8_SB(1, 0), b3, voffB); PG8_STAGE(PG8_SB(1, 1), b3 + hstep, voffB); PG8_STAGE(PG8_SA(1, 0), a3, voffA);
            PG8_WAIT_V(8); PG8_WAIT_L(0); PG8_BAR; PG8_MMA(1, 0, At, B0); PG8_MMA(1, 1, At, B1); PG8_BAR; PG8_SCHED;
            } else {
            PG8_LDB(B0, 0, 0); PG8_SCHED; PG8_LDA(At, 0, 0); PG8_STAGE(PG8_SA(1, 1), a1 + hstep, voffA);
            PG8_WAIT_L(8); PG8_BAR; PG8_WAIT_L(0); PG8_MMA(0, 0, At, B0); PG8_BAR; PG8_SCHED;
            PG8_LDB(B1, 0, 1); PG8_STAGE(PG8_SB(0, 0), b2, voffB);
            PG8_BAR; PG8_WAIT_L(0); PG8_MMA(0, 1, At, B1); PG8_BAR;
            PG8_LDA(At, 0, 1); PG8_STAGE(PG8_SA(0, 0), a2, voffA);
            PG8_BAR; PG8_WAIT_L(0); PG8_MMA(1, 0, At, B0); PG8_BAR; PG8_SCHED;
            PG8_STAGE(PG8_SB(0, 1), b2 + hstep, voffB);
            PG8_WAIT_V(6); PG8_BAR; PG8_MMA(1, 1, At, B1); PG8_BAR;
            PG8_LDB(B0, 1, 0); PG8_SCHED; PG8_LDA(At, 1, 0); PG8_STAGE(PG8_SA(0, 1), a2 + hstep, voffA);
            PG8_WAIT_L(8); PG8_BAR; PG8_WAIT_L(0); PG8_MMA(0, 0, At, B0); PG8_BAR; PG8_SCHED;
            PG8_LDB(B1, 1, 1); PG8_STAGE(PG8_SB(1, 0), b3, voffB);
            PG8_BAR; PG8_WAIT_L(0); PG8_MMA(0, 1, At, B1); PG8_BAR;
            PG8_LDA(At, 1, 1); PG8_STAGE(PG8_SA(1, 0), a3, voffA);
            PG8_BAR; PG8_WAIT_L(0); PG8_MMA(1, 0, At, B0); PG8_BAR; PG8_SCHED;
            PG8_STAGE(PG8_SB(1, 1), b3 + hstep, voffB);
            PG8_WAIT_V(6); PG8_BAR; PG8_MMA(1, 1, At, B1); PG8_BAR;
            }
        }
        if constexpr (ALIGN_EPI) { if (wr == 0) PG8_BAR; }
        if constexpr (!Epi::AFTER_DRAIN) { E(acc, cur, wr, wc, fr, fq, eaux); S.done(cur); if (has_next) E.pre(nxt, wr, fr, eaux); }
        if (!has_next) break;
#pragma unroll
        for (int a = 0; a < 2; ++a)
#pragma unroll
            for (int b = 0; b < 2; ++b)
#pragma unroll
                for (int m = 0; m < 4; ++m)
#pragma unroll
                    for (int n = 0; n < 2; ++n) acc[a][b][m][n] = (f32x4){0.f, 0.f, 0.f, 0.f};
        cur = nxt; cA = nA; cB = nB; ++ui;
        if constexpr (ALIGN_EPI) { if (wr == 1) PG8_BAR; }
    }
    PG8_WAIT_V(0);
    if constexpr (!ALIGN_EPI) { if (wr == 0) PG8_BAR; }
    PG8_BAR;
    if constexpr (Epi::AFTER_DRAIN) { E.fused(acc, cur, wr, wc, fr, fq, lds, wid, lane); S.done(cur); }
#undef PG8_SA
#undef PG8_SB
#undef PG8_STAGE
#undef PG8_LDA
#undef PG8_LDB
#undef PG8_MMA
#undef PG8_WAIT_V
#undef PG8_WAIT_L
#undef PG8_BAR
#undef PG8_SCHED
}
}
constexpr int NWAVES = 8;
constexpr int DM = 4096, SEQ = 4096, BATCH = 4, NMETA = 16, DEPTH = 2;
constexpr int MR = BATCH * SEQ;
constexpr int MROWS = MR + NMETA;
constexpr int MP = 65 * 256;
constexpr int INC = 14336, FF = 16384, AW = 2048;
constexpr int C_AQ = 0, C_AF = 2048, C_AI = 4096, C_AG = 6144, C_BQ = 8192, C_BK = 10240, C_BV = 12288;
constexpr float EPS = 1e-6f;
constexpr float LOG2E = 1.4426950408889634f;
constexpr float QSCALE = 0.125f * LOG2E;

constexpr size_t MiB = 1u << 20;
constexpr size_t WS_CTL = 0, CTL_ZERO_BYTES = 2 * MiB;
constexpr size_t WS_SSQ = 1 * MiB, SSQ_STRIDE = 128 * 1024;
constexpr size_t WS_LB = WS_SSQ + 5 * SSQ_STRIDE;
constexpr size_t WS_WIN = 4 * MiB;
constexpr size_t WS_WOUT = WS_WIN + (size_t)2 * INC * DM * 2;
constexpr size_t WS_WUP = WS_WOUT + (size_t)2 * DM * DM * 2;
constexpr size_t WS_WDN = WS_WUP + (size_t)2 * FF * DM * 2;
constexpr size_t WS_HB = WS_WDN + (size_t)2 * FF * DM * 2;
constexpr size_t WS_O = WS_HB + (size_t)MP * DM * 2;
constexpr size_t WS_PZ = WS_O + (size_t)MP * DM * 2;
constexpr size_t WS_END = WS_PZ + (size_t)MP * FF * 2;
static_assert(WS_END <= (size_t)2048 * MiB, "d_ws map");
constexpr int CW_TMO = 0, CW_CODE = 1;
constexpr int CW_BAR = 4096;
constexpr int MAX_LAUNCH = 16;
constexpr int CW_Q = 61440;

constexpr int RING_OFF = 0, RING_BYTES = 131072;
constexpr int LDS_BYTES = 163840;
constexpr int LDSCTL_OFF = LDS_BYTES - 1024, MISC_OFF = LDSCTL_OFF + 320;
#define GAS __attribute__((address_space(1)))
#define LAS __attribute__((address_space(3)))
typedef unsigned short bf16;
typedef unsigned v4u __attribute__((ext_vector_type(4)));
typedef float f32x4 __attribute__((ext_vector_type(4)));
typedef short bf16x8 __attribute__((ext_vector_type(8)));
typedef GAS unsigned gu32;
typedef GAS unsigned long long gu64;
#define RLX_AGENT __ATOMIC_RELAXED, __HIP_MEMORY_SCOPE_AGENT
#define LDS_WAIT() asm volatile("s_waitcnt lgkmcnt(0)" ::: "memory")
#define VM_WAIT() asm volatile("s_waitcnt vmcnt(0)" ::: "memory")
__device__ __forceinline__ unsigned long long rt() { return __builtin_amdgcn_s_memrealtime(); }
typedef float f32x2v_ __attribute__((ext_vector_type(2))); typedef __bf16 bf16x2v_ __attribute__((ext_vector_type(2)));
__device__ __forceinline__ unsigned pk2(float lo, float hi) { f32x2v_ v = {lo, hi}; bf16x2v_ r = __builtin_convertvector(v, bf16x2v_); return __builtin_bit_cast(unsigned, r); }
__device__ __forceinline__ unsigned f2bf(float f) { return pk2(f, 0.f) & 0xffffu; }

#define XB_TMO      128
#define XB_XCNT(j)  (256  + 64 * (j))
#define XB_XSUB(j)  (1280 + 64 * (j))
#define XB_XGEN(j)  (2304 + 64 * (j))
#define XB_TOP      3328
#define XB_TOPGEN   3392
#define XCD_BAR_WORDS 3456
#define XB_SPIN_CAP (1u << 18)

__device__ __forceinline__ unsigned xb_ld(unsigned* p)              { return __hip_atomic_load(p, __ATOMIC_RELAXED, __HIP_MEMORY_SCOPE_AGENT); }
__device__ __forceinline__ unsigned xb_add(unsigned* p, unsigned v) { return __hip_atomic_fetch_add(p, v, __ATOMIC_RELAXED, __HIP_MEMORY_SCOPE_AGENT); }
__device__ __forceinline__ unsigned xb_xcc_id() { return (unsigned)__builtin_amdgcn_s_getreg((3 << 11) | 20) & 0xFu; }
#define XB_SPIN(cond, bar) do { unsigned _sp = 0; while (cond) { __builtin_amdgcn_s_sleep(1); \
    if ((++_sp & 255u) == 0u) { if (xb_ld(&(bar)[XB_TMO])) break; if (_sp > XB_SPIN_CAP) { atomicAdd(&(bar)[XB_TMO], 1u); break; } } } } while (0)

struct XcdBarrier {
    unsigned* bar; unsigned x;
    volatile LAS unsigned* st;
};

__device__ __forceinline__ XcdBarrier xcd_barrier_post(unsigned* bar, volatile LAS unsigned* st) {
    XcdBarrier b; b.bar = bar; b.x = xb_xcc_id(); b.st = st;
    if (threadIdx.x == 0) (void)xb_add(&bar[XB_XCNT(b.x)], 1u);
    return b;
}
__device__ __forceinline__ void xcd_barrier_complete(unsigned* bar, unsigned x, unsigned& nloc, unsigned& nx) {
    const unsigned G = gridDim.x * gridDim.y * gridDim.z;
    unsigned sum, cnt, mine, sp = 0u;
    for (;;) {
        sum = 0u; cnt = 0u; mine = 0u;
#pragma unroll
        for (unsigned j = 0; j < 16; ++j) { const unsigned c = xb_ld(&bar[XB_XCNT(j)]); sum += c; cnt += (c > 0u) ? 1u : 0u; mine = (j == x) ? c : mine; }
        if (sum == G) break;
        __builtin_amdgcn_s_sleep(1);
        if ((++sp & 255u) == 0u) { if (xb_ld(&bar[XB_TMO])) break; if (sp > XB_SPIN_CAP) { atomicAdd(&bar[XB_TMO], 1u); break; } }
    }
    nloc = mine > 0u ? mine : 1u; nx = cnt > 0u ? cnt : 1u;
}

__device__ __forceinline__ void xcd_barrier(const XcdBarrier& b) {
    asm volatile("s_waitcnt vmcnt(0)" ::: "memory");
    __syncthreads();
    if (threadIdx.x == 0) {
        unsigned* bar = b.bar;
        __builtin_amdgcn_s_waitcnt(0);
        unsigned nloc = b.st[0], nx = b.st[1];
        if (nloc == 0u) { xcd_barrier_complete(bar, b.x, nloc, nx); b.st[0] = nloc; b.st[1] = nx; }
        const unsigned old = xb_add(&bar[XB_XSUB(b.x)], 1u);
        const unsigned gen = old / nloc;
        if (old + 1u == (gen + 1u) * nloc) {
            __builtin_amdgcn_fence(__ATOMIC_RELEASE, "agent");
            asm volatile("s_waitcnt vmcnt(0)" ::: "memory");
            const unsigned og = xb_add(&bar[XB_TOP], 1u);
            const unsigned tg = og / nx;
            if (og + 1u == (tg + 1u) * nx) xb_add(&bar[XB_TOPGEN], 1u);
            else XB_SPIN(xb_ld(&bar[XB_TOPGEN]) == tg, bar);
            __builtin_amdgcn_fence(__ATOMIC_ACQUIRE, "agent");
            xb_add(&bar[XB_XGEN(b.x)], 1u);
            asm volatile("s_waitcnt vmcnt(0)" ::: "memory");
        } else {
            XB_SPIN(xb_ld(&bar[XB_XGEN(b.x)]) == gen, bar);
            __builtin_amdgcn_fence(__ATOMIC_ACQUIRE, "agent");
            asm volatile("s_waitcnt vmcnt(0)" ::: "memory");
        }
    }
    __syncthreads();
}
static_assert(CW_BAR + MAX_LAUNCH * XCD_BAR_WORDS <= CW_Q && (CW_Q + (2 * DEPTH * 2 + DEPTH) * 512) * 4 <= (int)WS_SSQ, "CTL words");
struct Frame {
    LAS unsigned char* lds;
    volatile LAS unsigned* MISC;
    gu32* ctl;
    int tid, lane, wave;
    int vcu, G;
};
__device__ __forceinline__ float wave_sum(float v) {
#pragma unroll
    for (int o = 1; o < 64; o <<= 1) v += __shfl_xor(v, o);
    return v;
}
__device__ __forceinline__ float wave_max(float v) {
#pragma unroll
    for (int o = 1; o < 64; o <<= 1) v = fmaxf(v, __shfl_xor(v, o));
    return v;
}
typedef float f32x2 __attribute__((ext_vector_type(2)));
__device__ __forceinline__ float bf2f(unsigned short b) { return __uint_as_float((unsigned)b << 16); }
__device__ __forceinline__ float sigmoidf_(float x) { return 1.0f / (1.0f + __expf(-x)); }

constexpr int CV_LDS_WAVE = 64 * 144;
__device__ __forceinline__ int cv_perm(int n, int perm_lo, int perm_hi) {
    if (n >= perm_lo && n < perm_hi) { const int blk = (n & 255) >> 5, wc = blk >> 1, bj = blk & 1; return (n & ~255) + 32 * (4 * bj + wc) + (n & 31); }
    return n; }
__device__ __forceinline__ void p0_convert_unit(const float* W, int K, int N, bf16* WT, const float* g, int perm_lo, int perm_hi, int unit, int lane, LAS unsigned char* tile) {
    const int nb = N / 64, nblk = unit % nb, kseg = unit / nb, n = nblk * 64 + lane, k0 = kseg * 512;
    const GAS float* __restrict__ src = (const GAS float*)W + (size_t)k0 * N + n;
    float va[32], vb[32];
#define CV_LOAD(v_, h_) do { _Pragma("unroll") for (int j = 0; j < 32; ++j) v_[j] = __builtin_nontemporal_load(src + (size_t)((h_) * 32 + j) * N); } while (0)
#define CV_PACK(p_, v_, h_) do { if (g) { _Pragma("unroll") for (int j = 0; j < 32; ++j) v_[j] *= g[k0 + (h_) * 32 + j]; } \
        _Pragma("unroll") for (int q = 0; q < 4; ++q) p_[q] = (v4u){pk2(v_[8 * q], v_[8 * q + 1]), pk2(v_[8 * q + 2], v_[8 * q + 3]), pk2(v_[8 * q + 4], v_[8 * q + 5]), pk2(v_[8 * q + 6], v_[8 * q + 7])}; } while (0)
    CV_LOAD(va, 0); CV_LOAD(vb, 1);
    for (int c = 0; c < 8; ++c) {
        v4u pa[4], pb[4];
        CV_PACK(pa, va, 2 * c);     if (c < 7) CV_LOAD(va, 2 * c + 2);
        CV_PACK(pb, vb, 2 * c + 1); if (c < 7) CV_LOAD(vb, 2 * c + 3);
#pragma unroll
        for (int q = 0; q < 4; ++q) { *(LAS v4u*)(tile + lane * 144 + q * 16) = pa[q]; *(LAS v4u*)(tile + lane * 144 + 64 + q * 16) = pb[q]; }
        LDS_WAIT(); asm volatile("" ::: "memory");
#pragma unroll
        for (int r8 = 0; r8 < 8; ++r8) { const int row = r8 * 8 + (lane >> 3); const v4u x = *(const LAS v4u*)(tile + row * 144 + (lane & 7) * 16);
            *(GAS v4u*)(WT + (size_t)cv_perm(nblk * 64 + row, perm_lo, perm_hi) * K + k0 + c * 64 + (lane & 7) * 8) = x; }
        LDS_WAIT(); asm volatile("" ::: "memory");
    }
#undef CV_LOAD
#undef CV_PACK
}
__device__ __forceinline__ void row_to_bf16_ssq(const float* xrow, bf16* orow, float* ssq, int lane) {
    const GAS f32x4* xr = (const GAS f32x4*)xrow + lane;
    GAS unsigned long long* o8 = (GAS unsigned long long*)orow + lane;
    float s = 0.f;
#pragma unroll
    for (int j = 0; j < 16; ++j) { const f32x4 v = xr[64 * j]; s += (v.x * v.x + v.y * v.y) + (v.z * v.z + v.w * v.w);
        o8[64 * j] = (unsigned long long)pk2(v.x, v.y) | ((unsigned long long)pk2(v.z, v.w) << 32); }
    s = wave_sum(s);
    if (lane == 0) *ssq = s;
}
__device__ __forceinline__ void attn_ref(Frame& F, const bf16* P, bf16* O, const float* lp, const float* og, int layer, int u_lo, int u_hi) {
    LAS float* qf = (LAS float*)(F.lds + RING_OFF); LAS float* sc = qf + 128; LAS float* red = sc + 2 * 4112; LAS float* pvr = red + 64;
    int tid_ = threadIdx.x; asm volatile("" : "+v"(tid_)); const int tid = tid_, lane = tid & 63, wave = __builtin_amdgcn_readfirstlane(tid >> 6);
    const float lam_init = 0.8f - 0.6f * __expf(-0.3f * (float)layer);
    float lam; { const float a = wave_sum(lp[lane] * lp[64 + lane]), c = wave_sum(lp[128 + lane] * lp[192 + lane]); lam = __expf(a) - __expf(c) + lam_init; }
    for (int unit = u_lo + F.vcu; unit < u_hi; unit += F.G) {
        const int row = unit >> 4, h = unit & 15; const bool meta = row >= MR; const int b = (row >> 12) & 3, t = row & 4095;
        const int qpos = meta ? row - MR : NMETA + t, nk = meta ? NMETA : NMETA + 64 * ((t >> 6) + 1);
        const float slope2 = exp2f(-0.5f * (float)(h + 1)) * LOG2E;
        if (tid < 128) qf[tid] = bf2f(P[(size_t)row * INC + C_BQ + h * 128 + tid]);
        __syncthreads();
        float m0 = -3.0e38f, m1 = -3.0e38f;
        for (int kp = tid; kp < nk; kp += 512) { const size_t krow = kp < NMETA ? (size_t)(MR + kp) : (size_t)b * SEQ + kp - NMETA; const bf16* kr = P + krow * INC + C_BK + h * 128;
            float s0 = 0.f, s1 = 0.f;
#pragma unroll
            for (int j = 0; j < 8; ++j) { const v4u a = *(const GAS v4u*)(kr + 8 * j), c = *(const GAS v4u*)(kr + 64 + 8 * j);
#pragma unroll
                for (int i = 0; i < 4; ++i) { s0 += qf[8 * j + 2 * i] * __uint_as_float(a[i] << 16) + qf[8 * j + 2 * i + 1] * __uint_as_float(a[i] & 0xffff0000u);
                                              s1 += qf[64 + 8 * j + 2 * i] * __uint_as_float(c[i] << 16) + qf[64 + 8 * j + 2 * i + 1] * __uint_as_float(c[i] & 0xffff0000u); } }
            const float bias = slope2 * fabsf((float)(qpos - kp)); s0 -= bias; s1 -= bias; sc[kp] = s0; sc[4112 + kp] = s1; m0 = fmaxf(m0, s0); m1 = fmaxf(m1, s1); }
        m0 = wave_max(m0); m1 = wave_max(m1); if (lane == 0) { red[wave] = m0; red[8 + wave] = m1; }
        __syncthreads();
        m0 = red[0]; m1 = red[8];
#pragma unroll
        for (int i = 1; i < 8; ++i) { m0 = fmaxf(m0, red[i]); m1 = fmaxf(m1, red[8 + i]); }
        float l0 = 0.f, l1 = 0.f;
        for (int kp = tid; kp < nk; kp += 512) { const float p0 = exp2f(sc[kp] - m0), p1 = exp2f(sc[4112 + kp] - m1); sc[kp] = p0; sc[4112 + kp] = p1; l0 += p0; l1 += p1; }
        l0 = wave_sum(l0); l1 = wave_sum(l1); if (lane == 0) { red[16 + wave] = l0; red[24 + wave] = l1; }
        __syncthreads();
        l0 = 0.f; l1 = 0.f;
#pragma unroll
        for (int i = 0; i < 8; ++i) { l0 += red[16 + i]; l1 += red[24 + i]; }
        { const int c = tid >> 8, kq = (tid >> 6) & 3, ep = tid & 63; float a0 = 0.f, a1 = 0.f;
            for (int kp = kq; kp < nk; kp += 4) { const size_t krow = kp < NMETA ? (size_t)(MR + kp) : (size_t)b * SEQ + kp - NMETA;
                const unsigned vv = *(const GAS unsigned*)(P + krow * INC + C_BV + h * 128 + 2 * ep); const float p = sc[c * 4112 + kp];
                a0 += p * __uint_as_float(vv << 16); a1 += p * __uint_as_float(vv & 0xffff0000u); }
            pvr[(c * 4 + kq) * 128 + 2 * ep] = a0; pvr[(c * 4 + kq) * 128 + 2 * ep + 1] = a1; }
        __syncthreads();
        float o = 0.f;
        if (tid < 128) { float o0 = 0.f, o1 = 0.f;
#pragma unroll
            for (int kq = 0; kq < 4; ++kq) { o0 += pvr[kq * 128 + tid]; o1 += pvr[(4 + kq) * 128 + tid]; }
            o = o0 / l0 - lam * (o1 / l1);
            const float ss = wave_sum(o * o); if (lane == 0) red[32 + wave] = ss; }
        __syncthreads();
        if (tid < 128) { const float ss = red[32] + red[33]; const float y = o * (1.0f / sqrtf(ss * (1.0f / 128.0f) + EPS)) * og[tid] * (1.0f - lam_init);
            O[(size_t)row * DM + AW + h * 128 + tid] = (bf16)f2bf(y); }
        __syncthreads();
    }
}
namespace fa {
typedef short bf16x8 __attribute__((ext_vector_type(8)));
typedef short s16x4 __attribute__((ext_vector_type(4)));
typedef float f32x16 __attribute__((ext_vector_type(16)));
typedef unsigned u32x4 __attribute__((ext_vector_type(4)));
typedef float f32x2_t __attribute__((ext_vector_type(2))); typedef __bf16 bf16x2_t __attribute__((ext_vector_type(2)));
typedef short v4i16_t __attribute__((ext_vector_type(4)));
constexpr int SLOTB = 32768, NSLOT = 4;
constexpr int L_WSF = NSLOT * SLOTB;
constexpr int L_X = 0, L_OST = 65536;
constexpr float THR = 6.0f;
__device__ __forceinline__ int CR(int r) { return (r & 3) + 8 * (r >> 2); }
__device__ __forceinline__ void glds16(const void* gsrc, unsigned lds_dst) { unsigned keep;
    asm volatile("s_mov_b32 %0, m0\n\ts_mov_b32 m0, %2\n\ts_nop 0\n\tglobal_load_lds_dwordx4 %1, off\n\ts_mov_b32 m0, %0" : "=&s"(keep) : "v"(gsrc), "s"(lds_dst) : "memory"); }
__device__ __forceinline__ unsigned cvtpk(float lo, float hi) { f32x2_t v = {lo, hi}; bf16x2_t b = __builtin_convertvector(v, bf16x2_t); return __builtin_bit_cast(unsigned, b); }
__device__ __forceinline__ s16x4 vtr(const LAS char* p) { return __builtin_bit_cast(s16x4, __builtin_amdgcn_ds_read_tr16_b64_v4i16((LAS v4i16_t*)p)); }
__device__ __forceinline__ float hmax32(float v) { auto rr = __builtin_amdgcn_permlane32_swap(__float_as_uint(v), __float_as_uint(v), false, false); return fmaxf(__uint_as_float(rr[0]), __uint_as_float(rr[1])); }
__device__ __forceinline__ float hsum32(float v) { auto rr = __builtin_amdgcn_permlane32_swap(__float_as_uint(v), __float_as_uint(v), false, false); return __uint_as_float(rr[0]) + __uint_as_float(rr[1]); }
#define FA_WAIT_BAR(N) asm volatile("s_waitcnt vmcnt(" #N ") lgkmcnt(0)\n\ts_barrier" ::: "memory")

__device__ __forceinline__ void attn_unit(const bf16* P, bf16* O, int b, int h, int qb, float lam, float lam_init, float skipnum, const float* og, LAS unsigned char* lds) {
    int tid_ = threadIdx.x; asm volatile("" : "+v"(tid_));
    const int lane = tid_ & 63, r32 = lane & 31, hi = lane >> 5, wid = __builtin_amdgcn_readfirstlane(tid_ >> 6), c = wid >> 2, rg = wid & 3;
    const float slope2 = __uint_as_float(__builtin_amdgcn_readfirstlane(__float_as_uint(exp2f(-0.5f * (float)(h + 1)) * LOG2E)));
    const float sl2 = 2.f * slope2, sl3 = 3.f * slope2, sl8 = 8.f * slope2, sl16 = 16.f * slope2, sl24 = 24.f * slope2, sl32 = 32.f * slope2;
    const unsigned lds0 = (unsigned)(uintptr_t)lds;
    const float dskip = skipnum / slope2;
    int jmin = (int)ceilf(((float)(128 * qb - 63) - dskip) * (1.0f / 64.0f)); jmin = jmin < 0 ? 0 : jmin;
    const bool has_meta = (jmin == 0) && ((float)(128 * qb + 1) <= dskip);
    const int NTr = 2 * qb + 2 - jmin, NT = __builtin_amdgcn_readfirstlane(NTr + (has_meta ? 1 : 0)), jown = 2 * qb + (rg >> 1);
    const size_t rowb = (size_t)b * SEQ;
    const float qposl = (float)(NMETA + qb * 128 + rg * 32 + r32);
    const int dk_row = 8 * wid + (lane >> 3), dk_col = C_BK + h * 128 + (((lane & 7) ^ ((dk_row >> 1) & 7)) << 3);
    int dv_row[2], dv_col[2];
#pragma unroll
    for (int pp = 0; pp < 2; ++pp) { const int pv = 2 * wid + pp; dv_row[pp] = 8 * (pv & 7) + (lane >> 3); dv_col[pp] = C_BV + h * 128 + (pv >> 3) * 64 + (((lane & 7) ^ (((dv_row[pp] >> 1) & 1) << 2)) << 3); }
#define FA_DMA(i_) do { const int i__ = (i_); const bool meta__ = (i__ >= NTr); const int j__ = 2 * qb + 1 - i__; const unsigned sl__ = lds0 + (unsigned)((i__ & (NSLOT - 1)) * SLOTB); \
        const size_t rk__ = meta__ ? (size_t)(MR + (dk_row & 15)) : rowb + 64 * j__ + dk_row; \
        glds16(P + rk__ * INC + dk_col, (unsigned)__builtin_amdgcn_readfirstlane(sl__ + wid * 1024)); \
        glds16(P + rk__ * INC + dk_col + 64, (unsigned)__builtin_amdgcn_readfirstlane(sl__ + 8192 + wid * 1024)); \
        _Pragma("unroll") for (int pp = 0; pp < 2; ++pp) { const size_t rv__ = meta__ ? (size_t)(MR + (dv_row[pp] & 15)) : rowb + 64 * j__ + dv_row[pp]; \
            glds16(P + rv__ * INC + dv_col[pp], (unsigned)__builtin_amdgcn_readfirstlane(sl__ + 16384 + (2 * wid + pp) * 1024)); } } while (0)
    asm volatile("s_waitcnt vmcnt(0)" ::: "memory");
    bf16x8 qf[4];
    { const bf16* Qw = P + (rowb + qb * 128 + rg * 32 + r32) * INC + C_BQ + h * 128 + c * 64 + hi * 8;
#pragma unroll
      for (int d0 = 0; d0 < 4; ++d0) qf[d0] = *(const GAS bf16x8*)(Qw + d0 * 16); }
    FA_DMA(0); FA_DMA(1);
    f32x16 o[4];
#pragma unroll
    for (int d0 = 0; d0 < 4; ++d0)
#pragma unroll
        for (int r = 0; r < 16; ++r) o[d0][r] = 0.f;
    float mhat = -32.f, lsum = 0.f;
    LAS float* wsf = (LAS float*)(lds + L_WSF) + wid * 64;
    const LAS char* ldsc = (const LAS char*)lds;
    const int km7 = (r32 >> 1) & 7;
    int vbo0, vbo1; { const int q_ = (lane & 15) >> 2, p_ = lane & 3, blk_ = (lane >> 4) & 1, sw_ = ((q_ >> 1) & 1) << 2;
        vbo0 = (4 * hi + q_) * 128 + (((2 * blk_ + (p_ >> 1)) ^ sw_) << 4) + (p_ & 1) * 8; vbo1 = (4 * hi + q_) * 128 + (((4 + 2 * blk_ + (p_ >> 1)) ^ sw_) << 4) + (p_ & 1) * 8; }
    for (int i = 0; i < NT; ++i) {
        const int slot = (i & (NSLOT - 1)) * SLOTB;
        if ((i & 1) == 0) { FA_WAIT_BAR(0);
            if (i + 2 < NT) FA_DMA(i + 2);
            if (i + 3 < NT) FA_DMA(i + 3); }
        const bool meta = (i >= NTr); const int j = 2 * qb + 1 - i;
        if (!meta && j > jown) continue;
        const bool general = meta || (j == jown);
        const LAS char* Ks = ldsc + slot + c * 8192 + r32 * 128; asm volatile("" : "+v"(Ks));
        const float kvpos = meta ? 0.f : (float)(NMETA + 64 * j);
        f32x16 p0, p1;
        if (!general) { const float base = slope2 * (kvpos + (float)(4 * hi) - qposl) - mhat;
            const float t0 = base, t1 = base + slope2, t2 = base + sl2, t3 = base + sl3;
            p0[0] = t0; p0[1] = t1; p0[2] = t2; p0[3] = t3;
            p0[4] = t0 + sl8; p0[5] = t1 + sl8; p0[6] = t2 + sl8; p0[7] = t3 + sl8;
            p0[8] = t0 + sl16; p0[9] = t1 + sl16; p0[10] = t2 + sl16; p0[11] = t3 + sl16;
            p0[12] = t0 + sl24; p0[13] = t1 + sl24; p0[14] = t2 + sl24; p0[15] = t3 + sl24;
#pragma unroll
            for (int r = 0; r < 16; ++r) p1[r] = p0[r] + sl32; }
        else {
#pragma unroll
            for (int r = 0; r < 16; ++r) { p0[r] = 0.f; p1[r] = 0.f; } }
        { bf16x8 kf[8];
#pragma unroll
          for (int d0 = 0; d0 < 4; ++d0) { const int ko = ((2 * d0 + hi) ^ km7) << 4; kf[2 * d0] = *(const LAS bf16x8*)(Ks + ko); kf[2 * d0 + 1] = *(const LAS bf16x8*)(Ks + ko + 4096); }
          __builtin_amdgcn_sched_barrier(0);
#pragma unroll
          for (int d0 = 0; d0 < 4; ++d0) { p0 = __builtin_amdgcn_mfma_f32_32x32x16_bf16(kf[2 * d0], qf[d0], p0, 0, 0, 0); p1 = __builtin_amdgcn_mfma_f32_32x32x16_bf16(kf[2 * d0 + 1], qf[d0], p1, 0, 0, 0); }
          __builtin_amdgcn_sched_barrier(0); }
        if (general) {
#pragma unroll
            for (int r = 0; r < 16; ++r) { const float dq = qposl - kvpos - (float)(4 * hi);
                p0[r] = p0[r] - slope2 * fabsf(dq - (float)CR(r)) - mhat; p1[r] = p1[r] - slope2 * fabsf(dq - (float)(CR(r) + 32)) - mhat; }
            if (meta) {
#pragma unroll
                for (int r = 0; r < 16; ++r) { if (4 * hi + CR(r) >= NMETA) p0[r] = -1.0e30f; p1[r] = -1.0e30f; } }
        }
        float rm = fmaxf(p0[0], p1[0]);
#pragma unroll
        for (int r = 1; r < 16; ++r) rm = fmaxf(rm, fmaxf(p0[r], p1[r]));
        rm = hmax32(rm);
        if (__any(rm > THR)) { const float dl = fmaxf(rm, 0.f); mhat += dl;
#pragma unroll
            for (int r = 0; r < 16; ++r) { p0[r] -= dl; p1[r] -= dl; }
            const float f = exp2f(-dl); lsum *= f; if (hi == 0) wsf[r32] = f;
            LDS_WAIT();
#pragma unroll
            for (int r = 0; r < 16; ++r) { const float fr = wsf[CR(r) + 4 * hi];
#pragma unroll
                for (int d0 = 0; d0 < 4; ++d0) o[d0][r] *= fr; }
            LDS_WAIT(); }
        const LAS char* Vs0 = ldsc + slot + 16384 + vbo0; asm volatile("" : "+v"(Vs0)); const LAS char* Vs1 = ldsc + slot + 16384 + vbo1; asm volatile("" : "+v"(Vs1));
#define FA_VRD(dst, d0_, s_) do { const LAS char* vp_ = (((d0_) & 1) ? Vs1 : Vs0) + ((d0_) >> 1) * 8192 + (s_) * 2048; const s16x4 lo_ = vtr(vp_), hh_ = vtr(vp_ + 1024); dst = (bf16x8){lo_[0], lo_[1], lo_[2], lo_[3], hh_[0], hh_[1], hh_[2], hh_[3]}; } while (0)
#define FA_EX(P, i) do { P[i] = __builtin_amdgcn_exp2f(P[i]); ls += P[i]; } while (0)
#define FA_PK(P, B) __builtin_bit_cast(bf16x8, (u32x4){cvtpk(P[B], P[B + 1]), cvtpk(P[B + 2], P[B + 3]), cvtpk(P[B + 4], P[B + 5]), cvtpk(P[B + 6], P[B + 7])})
        float ls = 0.f; bf16x8 pa, pan, vf0, vf1, vf2;
        FA_VRD(vf0, 0, 0); FA_VRD(vf1, 1, 0);
        FA_EX(p0, 0); FA_EX(p0, 1); FA_EX(p0, 2); FA_EX(p0, 3); FA_EX(p0, 4); FA_EX(p0, 5); FA_EX(p0, 6); FA_EX(p0, 7); pa = FA_PK(p0, 0);
        __builtin_amdgcn_sched_barrier(0);
        FA_VRD(vf2, 2, 0); o[0] = __builtin_amdgcn_mfma_f32_32x32x16_bf16(pa, vf0, o[0], 0, 0, 0); FA_EX(p0, 8); FA_EX(p0, 9); __builtin_amdgcn_sched_barrier(0);
        FA_VRD(vf0, 3, 0); o[1] = __builtin_amdgcn_mfma_f32_32x32x16_bf16(pa, vf1, o[1], 0, 0, 0); FA_EX(p0, 10); FA_EX(p0, 11); __builtin_amdgcn_sched_barrier(0);
        FA_VRD(vf1, 0, 1); o[2] = __builtin_amdgcn_mfma_f32_32x32x16_bf16(pa, vf2, o[2], 0, 0, 0); FA_EX(p0, 12); FA_EX(p0, 13); __builtin_amdgcn_sched_barrier(0);
        FA_VRD(vf2, 1, 1); o[3] = __builtin_amdgcn_mfma_f32_32x32x16_bf16(pa, vf0, o[3], 0, 0, 0); FA_EX(p0, 14); FA_EX(p0, 15); pan = FA_PK(p0, 8); __builtin_amdgcn_sched_barrier(0);
        pa = pan;
        FA_VRD(vf0, 2, 1); o[0] = __builtin_amdgcn_mfma_f32_32x32x16_bf16(pa, vf1, o[0], 0, 0, 0); FA_EX(p1, 0); FA_EX(p1, 1); __builtin_amdgcn_sched_barrier(0);
        FA_VRD(vf1, 3, 1); o[1] = __builtin_amdgcn_mfma_f32_32x32x16_bf16(pa, vf2, o[1], 0, 0, 0); FA_EX(p1, 2); FA_EX(p1, 3); __builtin_amdgcn_sched_barrier(0);
        FA_VRD(vf2, 0, 2); o[2] = __builtin_amdgcn_mfma_f32_32x32x16_bf16(pa, vf0, o[2], 0, 0, 0); FA_EX(p1, 4); FA_EX(p1, 5); __builtin_amdgcn_sched_barrier(0);
        FA_VRD(vf0, 1, 2); o[3] = __builtin_amdgcn_mfma_f32_32x32x16_bf16(pa, vf1, o[3], 0, 0, 0); FA_EX(p1, 6); FA_EX(p1, 7); pan = FA_PK(p1, 0); __builtin_amdgcn_sched_barrier(0);
        pa = pan;
        FA_VRD(vf1, 2, 2); o[0] = __builtin_amdgcn_mfma_f32_32x32x16_bf16(pa, vf2, o[0], 0, 0, 0); FA_EX(p1, 8); FA_EX(p1, 9); __builtin_amdgcn_sched_barrier(0);
        FA_VRD(vf2, 3, 2); o[1] = __builtin_amdgcn_mfma_f32_32x32x16_bf16(pa, vf0, o[1], 0, 0, 0); FA_EX(p1, 10); FA_EX(p1, 11); __builtin_amdgcn_sched_barrier(0);
        FA_VRD(vf0, 0, 3); o[2] = __builtin_amdgcn_mfma_f32_32x32x16_bf16(pa, vf1, o[2], 0, 0, 0); FA_EX(p1, 12); FA_EX(p1, 13); __builtin_amdgcn_sched_barrier(0);
        FA_VRD(vf1, 1, 3); o[3] = __builtin_amdgcn_mfma_f32_32x32x16_bf16(pa, vf2, o[3], 0, 0, 0); FA_EX(p1, 14); FA_EX(p1, 15); pan = FA_PK(p1, 8); __builtin_amdgcn_sched_barrier(0);
        pa = pan;
        FA_VRD(vf2, 2, 3); o[0] = __builtin_amdgcn_mfma_f32_32x32x16_bf16(pa, vf0, o[0], 0, 0, 0); __builtin_amdgcn_sched_barrier(0);
        FA_VRD(vf0, 3, 3); o[1] = __builtin_amdgcn_mfma_f32_32x32x16_bf16(pa, vf1, o[1], 0, 0, 0); __builtin_amdgcn_sched_barrier(0);
        o[2] = __builtin_amdgcn_mfma_f32_32x32x16_bf16(pa, vf2, o[2], 0, 0, 0); __builtin_amdgcn_sched_barrier(0);
        o[3] = __builtin_amdgcn_mfma_f32_32x32x16_bf16(pa, vf0, o[3], 0, 0, 0); __builtin_amdgcn_sched_barrier(0);
        lsum += ls;
#undef FA_VRD
#undef FA_EX
#undef FA_PK
    }
    lsum = hsum32(lsum);
    FA_WAIT_BAR(0);
    { const float inv = (c == 0 ? 1.0f : -lam) / lsum; if (hi == 0) wsf[r32] = inv; LDS_WAIT();
#pragma unroll
      for (int r = 0; r < 16; ++r) { const float fr = wsf[CR(r) + 4 * hi];
#pragma unroll
          for (int d0 = 0; d0 < 4; ++d0) o[d0][r] *= fr; } }
    LAS float* X = (LAS float*)(lds + L_X) + rg * 4096 + lane;
    if (c == 1) {
#pragma unroll
        for (int d0 = 0; d0 < 4; ++d0)
#pragma unroll
            for (int r = 0; r < 16; ++r) X[(d0 * 16 + r) * 64] = o[d0][r]; }
    FA_WAIT_BAR(0);
    if (c == 0) {
        float rs[16];
#pragma unroll
        for (int r = 0; r < 16; ++r) { float ss = 0.f;
#pragma unroll
            for (int d0 = 0; d0 < 4; ++d0) { o[d0][r] += X[(d0 * 16 + r) * 64]; ss += o[d0][r] * o[d0][r]; }
#pragma unroll
            for (int m = 1; m < 32; m <<= 1) ss += __shfl_xor(ss, m);
            rs[r] = __builtin_amdgcn_rsqf(ss * (1.0f / 128.0f) + EPS) * (1.0f - lam_init); }
        LAS bf16* stg = (LAS bf16*)(lds + L_OST + rg * 8192);
#pragma unroll
        for (int d0 = 0; d0 < 4; ++d0) { const float g = og[d0 * 32 + r32];
#pragma unroll
            for (int r = 0; r < 16; ++r) stg[(CR(r) + 4 * hi) * 128 + d0 * 32 + r32] = (bf16)f2bf(o[d0][r] * rs[r] * g); }
        LDS_WAIT();
        bf16* Ow = O + (rowb + qb * 128 + rg * 32) * DM + AW + h * 128;
#pragma unroll
        for (int k = 0; k < 8; ++k) { const int row = k * 4 + (lane >> 4), ch = lane & 15; const u32x4 v = *(const LAS u32x4*)(stg + row * 128 + ch * 8); *(GAS u32x4*)(Ow + (size_t)row * DM + ch * 8) = v; }
    }
    FA_WAIT_BAR(0);
#undef FA_DMA
}
__device__ __forceinline__ void attn_phase(Frame& F, const bf16* P, bf16* O, const float* lp, const float* og, int layer) {
    const float lam_init = 0.8f - 0.6f * __expf(-0.3f * (float)layer);
    float lam; { const int lane = threadIdx.x & 63; const float a = wave_sum(lp[lane] * lp[64 + lane]), cc = wave_sum(lp[128 + lane] * lp[192 + lane]); lam = __expf(a) - __expf(cc) + lam_init; }
    for (int v = F.vcu; v < 256; v += F.G) { const int bh = v >> 2, s = v & 3;
        for (int k = 0; k < 8; ++k) { const int qb = (k & 1) ? 31 - 4 * (k >> 1) - s : 4 * (k >> 1) + s;
            attn_unit(P, O, bh >> 4, bh & 15, qb, lam, lam_init, 1.0e30f, og, F.lds + RING_OFF); } }
}
#undef FA_WAIT_BAR
}
namespace hg {
typedef short bf16x8 __attribute__((ext_vector_type(8)));
typedef float f32x16 __attribute__((ext_vector_type(16)));
typedef unsigned u32x2 __attribute__((ext_vector_type(2)));
constexpr int RQ = 272, RS = 144;
constexpr int L_QED = 0, L_KED = L_QED + 64 * RQ, L_QB = L_KED + 64 * RQ, L_QEO = L_QB + 64 * RQ, L_KEO = L_QEO + 32 * RQ, L_KDT = L_KEO + 32 * RQ, L_VT = L_KDT + 128 * RS,
              L_A = L_VT + 128 * RS, L_ST = L_A + 64 * RS, L_SEG = L_ST + 128 * RQ, L_BL = L_SEG + 4096, L_END = L_BL + 512;
#define HG_BAR() do { asm volatile("s_waitcnt lgkmcnt(0)" ::: "memory"); __builtin_amdgcn_s_barrier(); asm volatile("" ::: "memory"); } while (0)
__device__ __forceinline__ float bflo(unsigned u) { return __uint_as_float(u << 16); }
__device__ __forceinline__ float bfhi(unsigned u) { return __uint_as_float(u & 0xffff0000u); }

__device__ __forceinline__ void hgrn_chain(const bf16* P, bf16* O, const float* lbraw, const float* og, int layer, int b, int h, LAS unsigned char* lds) {
    int tid_ = threadIdx.x; asm volatile("" : "+v"(tid_));
    const int tid = tid_, lane = tid & 63, wid = __builtin_amdgcn_readfirstlane(tid >> 6);
    const int d0 = 2 * lane, to = wid, half = wid >> 2;
    for (int i = tid; i < 128 * RQ / 4; i += 512) ((LAS unsigned*)(lds + L_ST))[i] = 0u;
    f32x16 sacc[4];
#pragma unroll
    for (int dt = 0; dt < 4; ++dt)
#pragma unroll
        for (int r = 0; r < 16; ++r) sacc[dt][r] = 0.f;
    const size_t rowb = (size_t)b * SEQ;
    unsigned qraw[8], fraw[8], vraw[8];
#define HG_ROW(s_, t_) ((s_) == 0 ? (size_t)(MR + ((t_) & 15)) : rowb + (size_t)((s_) - 1) * 64 + (t_))
#define HG_LOAD(s_) do { _Pragma("unroll") for (int i = 0; i < 8; ++i) { const bf16* rp = P + HG_ROW(s_, 8 * to + i) * INC + h * 128 + d0; \
        qraw[i] = *(const GAS unsigned*)(rp + C_AQ); fraw[i] = *(const GAS unsigned*)(rp + C_AF); vraw[i] = *(const GAS unsigned*)(rp + C_AI); } } while (0)
    HG_LOAD(0);
    HG_BAR();
    for (int s = 0; s <= 64; ++s) {
        const bool meta = (s == 0);
        float bl[2][8], qv[2][8], kv[2][8]; unsigned vv[8];
        { float run0 = 0.f, run1 = 0.f;
#pragma unroll
          for (int i = 0; i < 8; ++i) { const bool pad = meta && (8 * to + i >= NMETA);
              float lf0 = bflo(fraw[i]), lf1 = bfhi(fraw[i]);
              float k0 = 1.0f - __expf(lf0), k1 = 1.0f - __expf(lf1);
              float q0 = bflo(qraw[i]), q1 = bfhi(qraw[i]); unsigned v = vraw[i];
              if (pad) { lf0 = 0.f; lf1 = 0.f; k0 = 0.f; k1 = 0.f; q0 = 0.f; q1 = 0.f; v = 0u; }
              run0 += lf0; run1 += lf1; bl[0][i] = run0; bl[1][i] = run1; qv[0][i] = q0; qv[1][i] = q1; kv[0][i] = k0; kv[1][i] = k1; vv[i] = v; }
          *(LAS f32x2*)(lds + L_SEG + (to * 128 + d0) * 4) = (f32x2){run0, run1}; }
        if (s < 64) HG_LOAD(s + 1);
        HG_BAR();
        {   f32x2 sg[8];
#pragma unroll
            for (int j = 0; j < 8; ++j) sg[j] = *(const LAS f32x2*)(lds + L_SEG + (j * 128 + d0) * 4);
            f32x2 off = {0.f, 0.f};
#pragma unroll
            for (int j = 0; j < 8; ++j) if (j < to) off += sg[j];
            const f32x2 b15 = sg[0] + sg[1], b31 = b15 + sg[2] + sg[3], b47 = b31 + sg[4] + sg[5], blast = b47 + sg[6] + sg[7];
            const f32x2 ref = half ? b47 : b15;
            if (to == 0) *(LAS f32x2*)(lds + L_BL + d0 * 4) = blast;
            float cqb[2], cx[2], ckd[2];
#pragma unroll
            for (int dd = 0; dd < 2; ++dd) { cqb[dd] = __expf(ref[dd]); cx[dd] = half ? __expf(ref[dd] - b31[dd]) : __expf(b31[dd] - ref[dd]); ckd[dd] = __expf(blast[dd] - ref[dd]); }
            unsigned kdp[2][4];
#pragma unroll
            for (int i = 0; i < 8; ++i) { const int t = 8 * to + i;
                float qe[2], ke[2];
#pragma unroll
                for (int dd = 0; dd < 2; ++dd) { const float E = __expf(__builtin_amdgcn_fmed3f(bl[dd][i] + off[dd] - ref[dd], -80.0f, 80.0f)); qe[dd] = qv[dd][i] * E; ke[dd] = kv[dd][i] * __builtin_amdgcn_rcpf(E); }
                *(LAS unsigned*)(lds + L_QED + t * RQ + d0 * 2) = pk2(qe[0], qe[1]);
                *(LAS unsigned*)(lds + L_KED + t * RQ + d0 * 2) = pk2(ke[0], ke[1]);
                *(LAS unsigned*)(lds + L_QB + t * RQ + d0 * 2) = pk2(qe[0] * cqb[0], qe[1] * cqb[1]);
                if (half) *(LAS unsigned*)(lds + L_QEO + (t - 32) * RQ + d0 * 2) = pk2(qe[0] * cx[0], qe[1] * cx[1]);
                else      *(LAS unsigned*)(lds + L_KEO + t * RQ + d0 * 2) = pk2(ke[0] * cx[0], ke[1] * cx[1]);
                const float kd0 = ke[0] * ckd[0], kd1 = ke[1] * ckd[1];
                if (i & 1) { kdp[0][i >> 1] |= f2bf(kd0) << 16; kdp[1][i >> 1] |= f2bf(kd1) << 16; } else { kdp[0][i >> 1] = f2bf(kd0); kdp[1][i >> 1] = f2bf(kd1); } }
#pragma unroll
            for (int dd = 0; dd < 2; ++dd) *(LAS v4u*)(lds + L_KDT + (d0 + dd) * RS + to * 16) = (v4u){kdp[dd][0], kdp[dd][1], kdp[dd][2], kdp[dd][3]};
            v4u vt0, vt1;
#pragma unroll
            for (int i = 0; i < 4; ++i) { vt0[i] = (vv[2 * i] & 0xffffu) | (vv[2 * i + 1] << 16); vt1[i] = (vv[2 * i] >> 16) | (vv[2 * i + 1] & 0xffff0000u); }
            *(LAS v4u*)(lds + L_VT + d0 * RS + to * 16) = vt0; *(LAS v4u*)(lds + L_VT + (d0 + 1) * RS + to * 16) = vt1;
        }
        HG_BAR();
        if (wid >= 4) {
            const int w = wid - 4, r32 = lane & 31, hi = lane >> 5;
            if (w < 3) {
                const LAS unsigned char* qs = lds + (w == 2 ? L_QEO : L_QED + (w == 1 ? 32 * RQ : 0)) + r32 * RQ + hi * 16;
                const LAS unsigned char* ks_ = lds + (w == 2 ? L_KEO : L_KED + (w == 1 ? 32 * RQ : 0)) + r32 * RQ + hi * 16;
                f32x16 a;
#pragma unroll
                for (int r = 0; r < 16; ++r) a[r] = 0.f;
                { bf16x8 ka[8], qa[8];
#pragma unroll
                  for (int k = 0; k < 8; ++k) { ka[k] = *(const LAS bf16x8*)(ks_ + k * 32); qa[k] = *(const LAS bf16x8*)(qs + k * 32); }
#pragma unroll
                  for (int k = 0; k < 8; ++k) a = __builtin_amdgcn_mfma_f32_32x32x16_bf16(ka[k], qa[k], a, 0, 0, 0); }
                const int t0 = w ? 32 : 0, s0 = (w == 1) ? 32 : 0;
#pragma unroll
                for (int g = 0; g < 4; ++g) { float v4[4];
#pragma unroll
                    for (int i = 0; i < 4; ++i) { const int sloc = 8 * g + 4 * hi + i; v4[i] = (w != 2 && sloc > r32) ? 0.f : a[4 * g + i]; }
                    *(LAS u32x2*)(lds + L_A + (t0 + r32) * RS + (s0 + 8 * g + 4 * hi) * 2) = (u32x2){pk2(v4[0], v4[1]), pk2(v4[2], v4[3])}; }
            }
#pragma unroll
            for (int r = 0; r < 16; ++r) { const float dec = __expf(*(const LAS float*)(lds + L_BL + (32 * w + (r & 3) + 8 * (r >> 2) + 4 * hi) * 4));
#pragma unroll
                for (int et = 0; et < 4; ++et) sacc[et][r] *= dec; }
            {
                const LAS unsigned char* kdp = lds + L_KDT + (32 * w + r32) * RS + hi * 16; const LAS unsigned char* vtp = lds + L_VT + r32 * RS + hi * 16;
#define HG_VT(dst, et_, k_) dst = *(const LAS bf16x8*)(vtp + (et_) * 32 * RS + (k_) * 32)
                bf16x8 af, afn, b0, b1, b2;
                af = *(const LAS bf16x8*)(kdp); HG_VT(b0, 0, 0); HG_VT(b1, 1, 0);
                __builtin_amdgcn_sched_barrier(0);
                HG_VT(b2, 2, 0); sacc[0] = __builtin_amdgcn_mfma_f32_32x32x16_bf16(af, b0, sacc[0], 0, 0, 0); __builtin_amdgcn_sched_barrier(0);
                HG_VT(b0, 3, 0); afn = *(const LAS bf16x8*)(kdp + 32); sacc[1] = __builtin_amdgcn_mfma_f32_32x32x16_bf16(af, b1, sacc[1], 0, 0, 0); __builtin_amdgcn_sched_barrier(0);
                HG_VT(b1, 0, 1); sacc[2] = __builtin_amdgcn_mfma_f32_32x32x16_bf16(af, b2, sacc[2], 0, 0, 0); __builtin_amdgcn_sched_barrier(0);
                HG_VT(b2, 1, 1); sacc[3] = __builtin_amdgcn_mfma_f32_32x32x16_bf16(af, b0, sacc[3], 0, 0, 0); __builtin_amdgcn_sched_barrier(0);
                af = afn;
                HG_VT(b0, 2, 1); sacc[0] = __builtin_amdgcn_mfma_f32_32x32x16_bf16(af, b1, sacc[0], 0, 0, 0); __builtin_amdgcn_sched_barrier(0);
                HG_VT(b1, 3, 1); afn = *(const LAS bf16x8*)(kdp + 64); sacc[1] = __builtin_amdgcn_mfma_f32_32x32x16_bf16(af, b2, sacc[1], 0, 0, 0); __builtin_amdgcn_sched_barrier(0);
                HG_VT(b2, 0, 2); sacc[2] = __builtin_amdgcn_mfma_f32_32x32x16_bf16(af, b0, sacc[2], 0, 0, 0); __builtin_amdgcn_sched_barrier(0);
                HG_VT(b0, 1, 2); sacc[3] = __builtin_amdgcn_mfma_f32_32x32x16_bf16(af, b1, sacc[3], 0, 0, 0); __builtin_amdgcn_sched_barrier(0);
                af = afn;
                HG_VT(b1, 2, 2); sacc[0] = __builtin_amdgcn_mfma_f32_32x32x16_bf16(af, b2, sacc[0], 0, 0, 0); __builtin_amdgcn_sched_barrier(0);
                HG_VT(b2, 3, 2); afn = *(const LAS bf16x8*)(kdp + 96); sacc[1] = __builtin_amdgcn_mfma_f32_32x32x16_bf16(af, b0, sacc[1], 0, 0, 0); __builtin_amdgcn_sched_barrier(0);
                HG_VT(b0, 0, 3); sacc[2] = __builtin_amdgcn_mfma_f32_32x32x16_bf16(af, b1, sacc[2], 0, 0, 0); __builtin_amdgcn_sched_barrier(0);
                HG_VT(b1, 1, 3); sacc[3] = __builtin_amdgcn_mfma_f32_32x32x16_bf16(af, b2, sacc[3], 0, 0, 0); __builtin_amdgcn_sched_barrier(0);
                af = afn;
                HG_VT(b2, 2, 3); sacc[0] = __builtin_amdgcn_mfma_f32_32x32x16_bf16(af, b0, sacc[0], 0, 0, 0); __builtin_amdgcn_sched_barrier(0);
                HG_VT(b0, 3, 3); sacc[1] = __builtin_amdgcn_mfma_f32_32x32x16_bf16(af, b1, sacc[1], 0, 0, 0); __builtin_amdgcn_sched_barrier(0);
                sacc[2] = __builtin_amdgcn_mfma_f32_32x32x16_bf16(af, b2, sacc[2], 0, 0, 0); __builtin_amdgcn_sched_barrier(0);
                sacc[3] = __builtin_amdgcn_mfma_f32_32x32x16_bf16(af, b0, sacc[3], 0, 0, 0); __builtin_amdgcn_sched_barrier(0);
#undef HG_VT
            }
            HG_BAR();
#pragma unroll
            for (int et = 0; et < 4; ++et)
#pragma unroll
                for (int g = 0; g < 4; ++g) *(LAS u32x2*)(lds + L_ST + (32 * et + r32) * RQ + (32 * w + 8 * g + 4 * hi) * 2) = (u32x2){pk2(sacc[et][4 * g], sacc[et][4 * g + 1]), pk2(sacc[et][4 * g + 2], sacc[et][4 * g + 3])};
        } else {
            const int t0 = 16 * wid, c15 = lane & 15, q4 = lane >> 4;
            const int t = t0 + c15; const bool valid = meta ? (t < NMETA && b == 0) : true;
            const size_t row = HG_ROW(s, t);
            u32x2 graw[8];
#pragma unroll
            for (int et = 0; et < 8; ++et) graw[et] = *(const GAS u32x2*)(P + row * INC + C_AG + h * 128 + 16 * et + 4 * q4);
            f32x4 oacc[8];
#pragma unroll
            for (int et = 0; et < 8; ++et) oacc[et] = (f32x4){0.f, 0.f, 0.f, 0.f};
            {
                const LAS unsigned char* stp = lds + L_ST + c15 * RQ + q4 * 16;
#define HG_ST(dst, et_, k_) dst = *(const LAS bf16x8*)(stp + (et_) * 16 * RQ + (k_) * 64)
                bf16x8 bq[4], a0, a1, a2, a3;
#pragma unroll
                for (int k = 0; k < 4; ++k) bq[k] = *(const LAS bf16x8*)(lds + L_QB + t * RQ + k * 64 + q4 * 16);
                HG_ST(a0, 0, 0); HG_ST(a1, 1, 0); HG_ST(a2, 2, 0);
                __builtin_amdgcn_sched_barrier(0);
                HG_ST(a3, 3, 0); oacc[0] = __builtin_amdgcn_mfma_f32_16x16x32_bf16(a0, bq[0], oacc[0], 0, 0, 0); __builtin_amdgcn_sched_barrier(0);
                HG_ST(a0, 4, 0); oacc[1] = __builtin_amdgcn_mfma_f32_16x16x32_bf16(a1, bq[0], oacc[1], 0, 0, 0); __builtin_amdgcn_sched_barrier(0);
                HG_ST(a1, 5, 0); oacc[2] = __builtin_amdgcn_mfma_f32_16x16x32_bf16(a2, bq[0], oacc[2], 0, 0, 0); __builtin_amdgcn_sched_barrier(0);
                HG_ST(a2, 6, 0); oacc[3] = __builtin_amdgcn_mfma_f32_16x16x32_bf16(a3, bq[0], oacc[3], 0, 0, 0); __builtin_amdgcn_sched_barrier(0);
                HG_ST(a3, 7, 0); oacc[4] = __builtin_amdgcn_mfma_f32_16x16x32_bf16(a0, bq[0], oacc[4], 0, 0, 0); __builtin_amdgcn_sched_barrier(0);
                HG_ST(a0, 0, 1); oacc[5] = __builtin_amdgcn_mfma_f32_16x16x32_bf16(a1, bq[0], oacc[5], 0, 0, 0); __builtin_amdgcn_sched_barrier(0);
                HG_ST(a1, 1, 1); oacc[6] = __builtin_amdgcn_mfma_f32_16x16x32_bf16(a2, bq[0], oacc[6], 0, 0, 0); __builtin_amdgcn_sched_barrier(0);
                HG_ST(a2, 2, 1); oacc[7] = __builtin_amdgcn_mfma_f32_16x16x32_bf16(a3, bq[0], oacc[7], 0, 0, 0); __builtin_amdgcn_sched_barrier(0);
                HG_ST(a3, 3, 1); oacc[0] = __builtin_amdgcn_mfma_f32_16x16x32_bf16(a0, bq[1], oacc[0], 0, 0, 0); __builtin_amdgcn_sched_barrier(0);
                HG_ST(a0, 4, 1); oacc[1] = __builtin_amdgcn_mfma_f32_16x16x32_bf16(a1, bq[1], oacc[1], 0, 0, 0); __builtin_amdgcn_sched_barrier(0);
                HG_ST(a1, 5, 1); oacc[2] = __builtin_amdgcn_mfma_f32_16x16x32_bf16(a2, bq[1], oacc[2], 0, 0, 0); __builtin_amdgcn_sched_barrier(0);
                HG_ST(a2, 6, 1); oacc[3] = __builtin_amdgcn_mfma_f32_16x16x32_bf16(a3, bq[1], oacc[3], 0, 0, 0); __builtin_amdgcn_sched_barrier(0);
                HG_ST(a3, 7, 1); oacc[4] = __builtin_amdgcn_mfma_f32_16x16x32_bf16(a0, bq[1], oacc[4], 0, 0, 0); __builtin_amdgcn_sched_barrier(0);
                HG_ST(a0, 0, 2); oacc[5] = __builtin_amdgcn_mfma_f32_16x16x32_bf16(a1, bq[1], oacc[5], 0, 0, 0); __builtin_amdgcn_sched_barrier(0);
                HG_ST(a1, 1, 2); oacc[6] = __builtin_amdgcn_mfma_f32_16x16x32_bf16(a2, bq[1], oacc[6], 0, 0, 0); __builtin_amdgcn_sched_barrier(0);
                HG_ST(a2, 2, 2); oacc[7] = __builtin_amdgcn_mfma_f32_16x16x32_bf16(a3, bq[1], oacc[7], 0, 0, 0); __builtin_amdgcn_sched_barrier(0);
                HG_ST(a3, 3, 2); oacc[0] = __builtin_amdgcn_mfma_f32_16x16x32_bf16(a0, bq[2], oacc[0], 0, 0, 0); __builtin_amdgcn_sched_barrier(0);
                HG_ST(a0, 4, 2); oacc[1] = __builtin_amdgcn_mfma_f32_16x16x32_bf16(a1, bq[2], oacc[1], 0, 0, 0); __builtin_amdgcn_sched_barrier(0);
                HG_ST(a1, 5, 2); oacc[2] = __builtin_amdgcn_mfma_f32_16x16x32_bf16(a2, bq[2], oacc[2], 0, 0, 0); __builtin_amdgcn_sched_barrier(0);
                HG_ST(a2, 6, 2); oacc[3] = __builtin_amdgcn_mfma_f32_16x16x32_bf16(a3, bq[2], oacc[3], 0, 0, 0); __builtin_amdgcn_sched_barrier(0);
                HG_ST(a3, 7, 2); oacc[4] = __builtin_amdgcn_mfma_f32_16x16x32_bf16(a0, bq[2], oacc[4], 0, 0, 0); __builtin_amdgcn_sched_barrier(0);
                HG_ST(a0, 0, 3); oacc[5] = __builtin_amdgcn_mfma_f32_16x16x32_bf16(a1, bq[2], oacc[5], 0, 0, 0); __builtin_amdgcn_sched_barrier(0);
                HG_ST(a1, 1, 3); oacc[6] = __builtin_amdgcn_mfma_f32_16x16x32_bf16(a2, bq[2], oacc[6], 0, 0, 0); __builtin_amdgcn_sched_barrier(0);
                HG_ST(a2, 2, 3); oacc[7] = __builtin_amdgcn_mfma_f32_16x16x32_bf16(a3, bq[2], oacc[7], 0, 0, 0); __builtin_amdgcn_sched_barrier(0);
                HG_ST(a3, 3, 3); oacc[0] = __builtin_amdgcn_mfma_f32_16x16x32_bf16(a0, bq[3], oacc[0], 0, 0, 0); __builtin_amdgcn_sched_barrier(0);
                HG_ST(a0, 4, 3); oacc[1] = __builtin_amdgcn_mfma_f32_16x16x32_bf16(a1, bq[3], oacc[1], 0, 0, 0); __builtin_amdgcn_sched_barrier(0);
                HG_ST(a1, 5, 3); oacc[2] = __builtin_amdgcn_mfma_f32_16x16x32_bf16(a2, bq[3], oacc[2], 0, 0, 0); __builtin_amdgcn_sched_barrier(0);
                HG_ST(a2, 6, 3); oacc[3] = __builtin_amdgcn_mfma_f32_16x16x32_bf16(a3, bq[3], oacc[3], 0, 0, 0); __builtin_amdgcn_sched_barrier(0);
                HG_ST(a3, 7, 3); oacc[4] = __builtin_amdgcn_mfma_f32_16x16x32_bf16(a0, bq[3], oacc[4], 0, 0, 0); __builtin_amdgcn_sched_barrier(0);
                oacc[5] = __builtin_amdgcn_mfma_f32_16x16x32_bf16(a1, bq[3], oacc[5], 0, 0, 0); __builtin_amdgcn_sched_barrier(0);
                oacc[6] = __builtin_amdgcn_mfma_f32_16x16x32_bf16(a2, bq[3], oacc[6], 0, 0, 0); __builtin_amdgcn_sched_barrier(0);
                oacc[7] = __builtin_amdgcn_mfma_f32_16x16x32_bf16(a3, bq[3], oacc[7], 0, 0, 0); __builtin_amdgcn_sched_barrier(0);
#undef HG_ST
            }
            HG_BAR();
            const int nks = (t0 < 32) ? 1 : 2;
            {
                const LAS unsigned char* vtq = lds + L_VT + c15 * RS + q4 * 16;
#define HG_VQ(dst, et_, k_) dst = *(const LAS bf16x8*)(vtq + (et_) * 16 * RS + (k_) * 64)
                bf16x8 a0, a1, a2, a3; const bf16x8 ba0 = *(const LAS bf16x8*)(lds + L_A + t * RS + q4 * 16), ba1 = *(const LAS bf16x8*)(lds + L_A + t * RS + 64 + q4 * 16);
                HG_VQ(a0, 0, 0); HG_VQ(a1, 1, 0); HG_VQ(a2, 2, 0);
                __builtin_amdgcn_sched_barrier(0);
                HG_VQ(a3, 3, 0); oacc[0] = __builtin_amdgcn_mfma_f32_16x16x32_bf16(a0, ba0, oacc[0], 0, 0, 0); __builtin_amdgcn_sched_barrier(0);
                HG_VQ(a0, 4, 0); oacc[1] = __builtin_amdgcn_mfma_f32_16x16x32_bf16(a1, ba0, oacc[1], 0, 0, 0); __builtin_amdgcn_sched_barrier(0);
                HG_VQ(a1, 5, 0); oacc[2] = __builtin_amdgcn_mfma_f32_16x16x32_bf16(a2, ba0, oacc[2], 0, 0, 0); __builtin_amdgcn_sched_barrier(0);
                HG_VQ(a2, 6, 0); oacc[3] = __builtin_amdgcn_mfma_f32_16x16x32_bf16(a3, ba0, oacc[3], 0, 0, 0); __builtin_amdgcn_sched_barrier(0);
                HG_VQ(a3, 7, 0); oacc[4] = __builtin_amdgcn_mfma_f32_16x16x32_bf16(a0, ba0, oacc[4], 0, 0, 0); __builtin_amdgcn_sched_barrier(0);
                if (nks == 2) { HG_VQ(a0, 0, 1); } oacc[5] = __builtin_amdgcn_mfma_f32_16x16x32_bf16(a1, ba0, oacc[5], 0, 0, 0); __builtin_amdgcn_sched_barrier(0);
                if (nks == 2) { HG_VQ(a1, 1, 1); } oacc[6] = __builtin_amdgcn_mfma_f32_16x16x32_bf16(a2, ba0, oacc[6], 0, 0, 0); __builtin_amdgcn_sched_barrier(0);
                if (nks == 2) { HG_VQ(a2, 2, 1); } oacc[7] = __builtin_amdgcn_mfma_f32_16x16x32_bf16(a3, ba0, oacc[7], 0, 0, 0); __builtin_amdgcn_sched_barrier(0);
                if (nks == 2) {
                    HG_VQ(a3, 3, 1); oacc[0] = __builtin_amdgcn_mfma_f32_16x16x32_bf16(a0, ba1, oacc[0], 0, 0, 0); __builtin_amdgcn_sched_barrier(0);
                    HG_VQ(a0, 4, 1); oacc[1] = __builtin_amdgcn_mfma_f32_16x16x32_bf16(a1, ba1, oacc[1], 0, 0, 0); __builtin_amdgcn_sched_barrier(0);
                    HG_VQ(a1, 5, 1); oacc[2] = __builtin_amdgcn_mfma_f32_16x16x32_bf16(a2, ba1, oacc[2], 0, 0, 0); __builtin_amdgcn_sched_barrier(0);
                    HG_VQ(a2, 6, 1); oacc[3] = __builtin_amdgcn_mfma_f32_16x16x32_bf16(a3, ba1, oacc[3], 0, 0, 0); __builtin_amdgcn_sched_barrier(0);
                    HG_VQ(a3, 7, 1); oacc[4] = __builtin_amdgcn_mfma_f32_16x16x32_bf16(a0, ba1, oacc[4], 0, 0, 0); __builtin_amdgcn_sched_barrier(0);
                    oacc[5] = __builtin_amdgcn_mfma_f32_16x16x32_bf16(a1, ba1, oacc[5], 0, 0, 0); __builtin_amdgcn_sched_barrier(0);
                    oacc[6] = __builtin_amdgcn_mfma_f32_16x16x32_bf16(a2, ba1, oacc[6], 0, 0, 0); __builtin_amdgcn_sched_barrier(0);
                    oacc[7] = __builtin_amdgcn_mfma_f32_16x16x32_bf16(a3, ba1, oacc[7], 0, 0, 0); __builtin_amdgcn_sched_barrier(0);
                }
#undef HG_VQ
            }
            float ss = 0.f;
#pragma unroll
            for (int et = 0; et < 8; ++et) { const f32x4 q = oacc[et] * oacc[et]; ss += (q[0] + q[1]) + (q[2] + q[3]); }
            ss += __shfl_xor(ss, 16); ss += __shfl_xor(ss, 32);
            const float rs = __builtin_amdgcn_rsqf(ss * (1.0f / 128.0f) + EPS);
            if (valid) {
#pragma unroll
                for (int et = 0; et < 8; ++et) { const f32x4 g4 = *(const f32x4*)(og + 16 * et + 4 * q4);
                    const float g0 = bflo(graw[et][0]), g1 = bfhi(graw[et][0]), g2 = bflo(graw[et][1]), g3 = bfhi(graw[et][1]);
                    const float y0 = oacc[et][0] * rs * g4[0] * (g0 * __builtin_amdgcn_rcpf(1.0f + __expf(-g0))), y1 = oacc[et][1] * rs * g4[1] * (g1 * __builtin_amdgcn_rcpf(1.0f + __expf(-g1)));
                    const float y2 = oacc[et][2] * rs * g4[2] * (g2 * __builtin_amdgcn_rcpf(1.0f + __expf(-g2))), y3 = oacc[et][3] * rs * g4[3] * (g3 * __builtin_amdgcn_rcpf(1.0f + __expf(-g3)));
                    *(GAS u32x2*)(O + row * DM + h * 128 + 16 * et + 4 * q4) = (u32x2){pk2(y0, y1), pk2(y2, y3)}; } }
        }
        HG_BAR();
    }
#undef HG_ROW
#undef HG_LOAD
}
#undef HG_BAR
}
namespace sk {
typedef short bf16x8 __attribute__((ext_vector_type(8)));
__device__ __forceinline__ float red32(float v) {
#pragma unroll
    for (int m = 1; m < 32; m <<= 1) v += __shfl_xor(v, m);
    return v; }
__device__ __forceinline__ float red16(float v) {
#pragma unroll
    for (int m = 1; m < 16; m <<= 1) v += __shfl_xor(v, m);
    return v; }
struct SkIn {
    bf16* P; const float* ssq; const float* gq; const float* gk; float qscale; const float* lb;
    static constexpr int NT = 4;
    __device__ __forceinline__ int slot(int u, int ct) const { return (u >> 2) * 256 + (ct >> 1) * 128 + 32 * (u & 3) + (ct & 1) * 16; }
    __device__ __forceinline__ void operator()(int u, int row, int c0, float v0, float v1) const {
        const float rs = __builtin_amdgcn_rsqf(ssq[MR + row] * (1.0f / DM) + EPS); v0 *= rs; v1 *= rs;
        if (u >= 128 && u < 192) { const float r2 = __builtin_amdgcn_rsqf(red32(v0 * v0 + v1 * v1) * (1.0f / 64.0f) + EPS);
            const float* g = (u < 160 ? gq : gk) + (u & 1) * 64 + c0; const float sc = u < 160 ? qscale : 1.f; v0 *= r2 * g[0] * sc; v1 *= r2 * g[1] * sc; }
        if (u >= 32 && u < 64) { const float* l2 = lb + 64 * (u - 32) + c0;
            v0 = fmaxf(__logf(l2[0] + (1.0f - l2[0]) * __builtin_amdgcn_rcpf(1.0f + __expf(-v0))), -60.0f); v1 = fmaxf(__logf(l2[1] + (1.0f - l2[1]) * __builtin_amdgcn_rcpf(1.0f + __expf(-v1))), -60.0f); }
        *(GAS unsigned*)(P + (size_t)(MR + row) * INC + 64 * u + c0) = pk2(v0, v1);
    }
};
struct SkUp {
    bf16* Z; const float* ssq;
    static constexpr int NT = 4;
    __device__ __forceinline__ int slot(int u, int ct) const { return (u >> 2) * 256 + (ct >> 1) * 128 + 32 * (u & 3) + (ct & 1) * 16; }
    __device__ __forceinline__ void operator()(int u, int row, int c0, float v0, float v1) const {
        const float rs = __builtin_amdgcn_rsqf(ssq[MR + row] * (1.0f / DM) + EPS); v0 = fmaxf(v0 * rs, 0.f); v1 = fmaxf(v1 * rs, 0.f);
        *(GAS unsigned*)(Z + (size_t)(MR + row) * FF + 64 * u + c0) = pk2(v0 * v0, v1 * v1);
    }
};
struct SkRes {
    const float* basef; bf16* HB; float* ssq;
    static constexpr int NT = 1;
    __device__ __forceinline__ int slot(int u, int ct) const { const int c = 16 * u, cc = c & 255; return (c & ~255) + 128 * ((cc >> 5) & 1) + 32 * (cc >> 6) + (cc & 31); }
    __device__ __forceinline__ void operator()(int u, int row, int c0, float v0, float) const {
        const int col = 16 * u + c0; const size_t o = (size_t)(MR + row) * DM + col;
        const float hv = (basef ? basef[(size_t)row * DM + col] : bf2f(HB[o])) + v0;
        HB[o] = (bf16)f2bf(hv);
        const float ss = red16(hv * hv); if (c0 == 0) atomicAdd(ssq + MR + row, ss);
    }
};
template <class Epi> __device__ __forceinline__ void skinny_phase(Frame& F, const bf16* A, const bf16* Bt, int N, int K, const Epi& E) {
    constexpr int NT = Epi::NT, CPT = (NT == 4) ? 2 : 1, TPR = 16 * NT / CPT;
    int tid_ = threadIdx.x; asm volatile("" : "+v"(tid_));
    const int tid = tid_, lane = tid & 63, wid = __builtin_amdgcn_readfirstlane(tid >> 6), c15 = lane & 15, q4 = lane >> 4;
    LAS float* red = (LAS float*)(F.lds + RING_OFF);
    const int units = N / (16 * NT), kw = K / 8, nks = kw / 32;
    for (int u = F.vcu; u < units; u += F.G) {
        f32x4 acc[NT];
#pragma unroll
        for (int ct = 0; ct < NT; ++ct) acc[ct] = (f32x4){0.f, 0.f, 0.f, 0.f};
        const bf16* ap = A + (size_t)c15 * K + wid * kw + 8 * q4;
        const bf16* bp[NT];
#pragma unroll
        for (int ct = 0; ct < NT; ++ct) bp[ct] = Bt + (size_t)(E.slot(u, ct) + c15) * K + wid * kw + 8 * q4;
#pragma unroll 4
        for (int ks = 0; ks < nks; ++ks) { const bf16x8 a = *(const GAS bf16x8*)(ap + 32 * ks);
#pragma unroll
            for (int ct = 0; ct < NT; ++ct) acc[ct] = __builtin_amdgcn_mfma_f32_16x16x32_bf16(*(const GAS bf16x8*)(bp[ct] + 32 * ks), a, acc[ct], 0, 0, 0); }
#pragma unroll
        for (int ct = 0; ct < NT; ++ct) *(LAS f32x4*)(red + (wid * 16 + c15) * (16 * NT) + 16 * ct + 4 * q4) = acc[ct];
        asm volatile("s_waitcnt lgkmcnt(0)" ::: "memory"); __builtin_amdgcn_s_barrier(); asm volatile("" ::: "memory");
        if (tid < 16 * TPR) { const int row = tid / TPR, c0 = (tid % TPR) * CPT; float v0 = 0.f, v1 = 0.f;
#pragma unroll
            for (int w = 0; w < 8; ++w) { v0 += red[(w * 16 + row) * (16 * NT) + c0]; if (CPT == 2) v1 += red[(w * 16 + row) * (16 * NT) + c0 + 1]; }
            E(u, row, c0, v0, v1); }
        asm volatile("s_waitcnt lgkmcnt(0)" ::: "memory"); __builtin_amdgcn_s_barrier(); asm volatile("" ::: "memory");
    }
}
}

struct Args { const float* in[14]; float* out; unsigned char* ws; int ph_lo, ph_hi, li, pad; };
constexpr int PH_PER_LAYER = 5, N_PHASES = 1 + DEPTH * PH_PER_LAYER;

constexpr int CU_IN = (DM / 512) * (INC / 64), CU_OUT = (DM / 512) * (DM / 64), CU_UP = (DM / 512) * (FF / 64), CU_DN = (FF / 512) * (DM / 64);
__device__ __forceinline__ void conv_mat(const Args& args, int mat, int l, int unit, int lane, LAS unsigned char* tile) {
    unsigned char* ws = args.ws;
    if (mat == 0) p0_convert_unit(args.in[3] + (size_t)l * DM * INC, DM, INC, (bf16*)(ws + WS_WIN) + (size_t)l * INC * DM, args.in[2] + l * DM, 0, INC, unit, lane, tile);
    else if (mat == 1) p0_convert_unit(args.in[10] + (size_t)l * DM * DM, DM, DM, (bf16*)(ws + WS_WOUT) + (size_t)l * DM * DM, nullptr, 0, DM, unit, lane, tile);
    else if (mat == 2) p0_convert_unit(args.in[12] + (size_t)l * DM * FF, DM, FF, (bf16*)(ws + WS_WUP) + (size_t)l * FF * DM, args.in[11] + l * DM, 0, FF, unit, lane, tile);
    else p0_convert_unit(args.in[13] + (size_t)l * FF * DM, FF, DM, (bf16*)(ws + WS_WDN) + (size_t)l * DM * FF, nullptr, 0, DM, unit, lane, tile);
}
constexpr int CV_N0 = CU_OUT + CU_UP + CU_DN + CU_IN, CV_N1 = CU_OUT + CU_UP + CU_DN;
__device__ __forceinline__ void conv_phase_unit(const Args& args, int layer, int wu, int lane, LAS unsigned char* tile) {
    if (wu >= (layer == 0 ? CV_N0 : CV_N1)) return;
    if (wu < CU_OUT) { conv_mat(args, 1, layer, wu, lane, tile); return; } wu -= CU_OUT;
    if (wu < CU_UP) { conv_mat(args, 2, layer, wu, lane, tile); return; } wu -= CU_UP;
    if (wu < CU_DN) { conv_mat(args, 3, layer, wu, lane, tile); return; } wu -= CU_DN;
    conv_mat(args, 0, 1, wu, lane, tile);
}
__device__ __forceinline__ void p0_prologue(Frame& F, const Args& args) {
    int tid_ = threadIdx.x; asm volatile("" : "+v"(tid_)); const int lane = tid_ & 63, wave = __builtin_amdgcn_readfirstlane(tid_ >> 6);
    const int gw = F.vcu * NWAVES + wave, NGW = F.G * NWAVES;
    unsigned char* ws = args.ws;
    for (int it = gw; it < CU_IN; it += NGW) conv_mat(args, 0, 0, it, lane, F.lds + RING_OFF + wave * CV_LDS_WAVE);
    if (gw < AW / 64) { const int c = gw * 64 + lane; ((float*)(ws + WS_LB))[AW + c] = 1.0f / (1.0f + __expf(args.in[4][c] - args.in[4][AW + c])); }
    bf16* HB = (bf16*)(ws + WS_HB); float* ssq0 = (float*)(ws + WS_SSQ);
    for (int m = gw; m < MROWS; m += NGW) row_to_bf16_ssq(m < MR ? args.in[0] + (size_t)m * DM : args.in[1] + (size_t)(m - MR) * DM, HB + (size_t)m * DM, ssq0 + m, lane);
}

__device__ __forceinline__ int mx_bh(int x, int k) { const int b = k & 3, hi = (k < 4); const int h = (b < 2) ? (hi ? 15 - x : x) : (hi ? 8 + x : 7 - x); return b * 16 + h; }
__device__ __forceinline__ int mx_grab(gu32* head, volatile LAS unsigned* slot) {
    asm volatile("s_waitcnt lgkmcnt(0)" ::: "memory"); __builtin_amdgcn_s_barrier(); asm volatile("" ::: "memory");
    if (threadIdx.x == 0) *slot = __hip_atomic_fetch_add(head, 1u, RLX_AGENT);
    asm volatile("s_waitcnt vmcnt(0) lgkmcnt(0)" ::: "memory"); __builtin_amdgcn_s_barrier(); asm volatile("" ::: "memory");
    return (int)*slot;
}
__device__ __forceinline__ void mixer_phase(Frame& F, const Args& args, const bf16* P, bf16* O, const float* lbraw, const float* hog, const float* lp, const float* aog, const float* qg, const float* kg, int layer, int rep, int kinds) {
    int tid_ = threadIdx.x; asm volatile("" : "+v"(tid_));
    const float lam_init = 0.8f - 0.6f * __expf(-0.3f * (float)layer);
    float lam; { const int lane = tid_ & 63; const float a = wave_sum(lp[lane] * lp[64 + lane]), cc = wave_sum(lp[128 + lane] * lp[192 + lane]); lam = __expf(a) - __expf(cc) + lam_init; }
    float skipnum; { const int lane = tid_ & 63;
        const float a = wave_max(fmaxf(fabsf(qg[lane]), fabsf(qg[64 + lane]))), bq = wave_max(fmaxf(fabsf(kg[lane]), fabsf(kg[64 + lane])));
        skipnum = 2.0f * (8.0f * a * bq * LOG2E * 1.02f) + 66.0f; }
    const int x0 = (int)(xb_xcc_id() & 7u);
    gu32* qc = F.ctl + CW_Q + ((rep * DEPTH + layer) * 2 + 0) * 512; gu32* qa = F.ctl + CW_Q + ((rep * DEPTH + layer) * 2 + 1) * 512;
    if (kinds & 1) for (int k = 0; k < 8; ++k) { const int qx = (x0 + k) & 7;
        for (;;) { const int i = mx_grab(qc + qx * 64, F.MISC + 16); if (i >= 8) break; const int bh = mx_bh(qx, i);
            hg::hgrn_chain(P, O, lbraw, hog, layer, bh >> 4, bh & 15, F.lds); } }
    gu32* qv = F.ctl + CW_Q + (2 * DEPTH * 2 + layer) * 512; const int ncv = ((layer == 0 ? CV_N0 : CV_N1) + 7) / 8; const int wave = __builtin_amdgcn_readfirstlane(tid_ >> 6);
    int adone = 0, cdone = 0; bool cv_left = (rep == 0);
    if (kinds & 2) for (int k = 0; k < 8; ++k) { const int qx = (x0 + k) & 7;
        for (;;) { const int i = mx_grab(qa + qx * 64, F.MISC + 16); if (i >= 256) break; const int bh = mx_bh(qx, i >> 5), qb = 31 - (i & 31);
            fa::attn_unit(P, O, bh >> 4, bh & 15, qb, lam, lam_init, skipnum, aog, F.lds + RING_OFF); ++adone;
            while (cv_left && cdone * 2048 < adone * ncv * 2) { const int ci = mx_grab(qv, F.MISC + 16); if (ci >= ncv) { cv_left = false; break; } conv_phase_unit(args, layer, ci * 8 + wave, tid_ & 63, F.lds + RING_OFF + wave * CV_LDS_WAVE); ++cdone; } } }
    while (cv_left) { const int ci = mx_grab(qv, F.MISC + 16); if (ci >= ncv) break; conv_phase_unit(args, layer, ci * 8 + wave, tid_ & 63, F.lds + RING_OFF + wave * CV_LDS_WAVE); }
}


__global__ void __launch_bounds__(NWAVES * 64, 2) fwd(Args args) {
    extern __shared__ __attribute__((aligned(16))) unsigned char lds[];
    asm volatile("s_nop 0"); asm volatile("s_nop 0"); asm volatile("s_nop 0"); asm volatile("s_nop 0");
    Frame F;
    F.lds = (LAS unsigned char*)lds;
    F.MISC = (volatile LAS unsigned*)(F.lds + MISC_OFF);
    F.tid = threadIdx.x; F.lane = F.tid & 63; F.wave = __builtin_amdgcn_readfirstlane(F.tid >> 6);
    F.G = gridDim.x; { const int bx = blockIdx.x; F.vcu = (F.G % 8 == 0) ? (bx % 8) * (F.G / 8) + bx / 8 : bx; }
    unsigned char* ws = args.ws;
    F.ctl = (gu32*)(ws + WS_CTL);
    for (int u = F.tid; u < (LDS_BYTES - LDSCTL_OFF) / 4; u += NWAVES * 64) ((LAS unsigned*)(F.lds + LDSCTL_OFF))[u] = 0u;
    __syncthreads();
    XcdBarrier bar = xcd_barrier_post((unsigned*)(F.ctl + CW_BAR) + args.li * XCD_BAR_WORDS, F.MISC + 8);
    const int lo = args.ph_lo, hi = args.ph_hi;
#define IN(k) (lo <= (k) && (k) < hi)
#define SEAM(k) do { if (IN(k) && IN((k) + 1)) xcd_barrier(bar); } while (0)
    bf16* WIN = (bf16*)(ws + WS_WIN); bf16* WOUT = (bf16*)(ws + WS_WOUT); bf16* WUP = (bf16*)(ws + WS_WUP); bf16* WDN = (bf16*)(ws + WS_WDN);
    bf16* HB = (bf16*)(ws + WS_HB); bf16* OB = (bf16*)(ws + WS_O); bf16* PZ = (bf16*)(ws + WS_PZ);

    if (IN(0)) p0_prologue(F, args);
    SEAM(0);

    for (int l = 0; l < DEPTH; ++l) {
        const int pb = 1 + l * PH_PER_LAYER;
        float* ssqA = (float*)(ws + WS_SSQ + (size_t)(2 * l) * SSQ_STRIDE); float* ssqB = (float*)(ws + WS_SSQ + (size_t)(2 * l + 1) * SSQ_STRIDE); float* ssqC = (float*)(ws + WS_SSQ + (size_t)(2 * l + 2) * SSQ_STRIDE);
        if (IN(pb + 0)) {
            pg8::Gemm g{HB, WIN + (size_t)l * INC * DM, MR, INC, DM}; pg8::StaticOrder S; S.init(MR, INC, F.G, (int)blockIdx.x);
            pg8::EpiIn E{PZ, INC, ssqA, args.in[6] + l * 128, args.in[7] + l * 128, QSCALE, (const float*)(ws + WS_LB) + l * AW};
            pg8::gemm_phase<pg8::EpiIn, pg8::StaticOrder, true, true>(F.lds + RING_OFF, g, S, E);
            sk::SkIn SE{PZ, ssqA, args.in[6] + l * 128, args.in[7] + l * 128, QSCALE, (const float*)(ws + WS_LB) + l * AW};
            sk::skinny_phase(F, HB + (size_t)MR * DM, WIN + (size_t)l * INC * DM, INC, DM, SE);
        }
        SEAM(pb + 0);
        if (IN(pb + 1)) {
            mixer_phase(F, args, PZ, OB, args.in[4], args.in[5] + l * 128, args.in[8] + l * 256, args.in[9] + l * 128, args.in[6] + l * 128, args.in[7] + l * 128, l, 0, 3);
            __syncthreads();
            attn_ref(F, PZ, OB, args.in[8] + l * 256, args.in[9] + l * 128, l, MR * 16, MROWS * 16);
        }
        SEAM(pb + 1);
        if (IN(pb + 2)) {
            pg8::Gemm g{OB, WOUT + (size_t)l * DM * DM, MR, DM, DM}; pg8::StaticOrder S; S.init(MR, DM, F.G, (int)blockIdx.x);
            pg8::EpiRes E{nullptr, HB, nullptr, ssqB};
            pg8::gemm_phase<pg8::EpiRes, pg8::StaticOrder, true, true>(F.lds + RING_OFF, g, S, E);
            sk::SkRes SE{nullptr, HB, ssqB};
            sk::skinny_phase(F, OB + (size_t)MR * DM, WOUT + (size_t)l * DM * DM, DM, DM, SE);
        }
        SEAM(pb + 2);
        if (IN(pb + 3)) {
            pg8::Gemm g{HB, WUP + (size_t)l * FF * DM, MR, FF, DM}; pg8::StaticOrder S; S.init(MR, FF, F.G, (int)blockIdx.x);
            pg8::EpiUp E{PZ, FF, ssqB};
            pg8::gemm_phase<pg8::EpiUp, pg8::StaticOrder, true, true>(F.lds + RING_OFF, g, S, E);
            sk::SkUp SE{PZ, ssqB};
            sk::skinny_phase(F, HB + (size_t)MR * DM, WUP + (size_t)l * FF * DM, FF, DM, SE);
        }
        SEAM(pb + 3);
        if (IN(pb + 4)) {
            const bool last = (l == DEPTH - 1);
            pg8::Gemm g{PZ, WDN + (size_t)l * DM * FF, MR, DM, FF}; pg8::StaticOrder S; S.init(MR, DM, F.G, (int)blockIdx.x);
            pg8::EpiRes E{nullptr, HB, last ? args.out : nullptr, ssqC};
            pg8::gemm_phase<pg8::EpiRes, pg8::StaticOrder, true, true>(F.lds + RING_OFF, g, S, E);
            if (!last) { sk::SkRes SE{nullptr, HB, ssqC};
                sk::skinny_phase(F, PZ + (size_t)MR * FF, WDN + (size_t)l * DM * FF, DM, FF, SE); }
        }
        SEAM(pb + 4);
    }
#undef IN
#undef SEAM
}

#ifndef MK_CUTS
#define MK_CUTS 0
#endif
extern "C" void kernel_launch(void* const* d_in, const int* in_sizes, int n_in, void* d_out, int out_size, void* d_ws, size_t ws_size, hipStream_t stream) {
    static int grid = 0;
    if (grid == 0) {
        if (n_in != 14 || in_sizes[0] != MR * DM || out_size != MR * DM || ws_size < WS_END) { fprintf(stderr, "kernel_launch: unexpected shapes / workspace (%d inputs, ws %zu < %zu)\n", n_in, ws_size, (size_t)WS_END); grid = -1; return; }
        int dev = 0, cus = 0, per_cu = 0;
        if (hipGetDevice(&dev) != hipSuccess || hipDeviceGetAttribute(&cus, hipDeviceAttributeMultiprocessorCount, dev) != hipSuccess) { grid = -1; return; }
        if (hipFuncSetAttribute((const void*)fwd, hipFuncAttributeMaxDynamicSharedMemorySize, LDS_BYTES) != hipSuccess) { fprintf(stderr, "kernel_launch: hipFuncSetAttribute failed\n"); grid = -1; return; }
        if (hipOccupancyMaxActiveBlocksPerMultiprocessor(&per_cu, (const void*)fwd, NWAVES * 64, LDS_BYTES) != hipSuccess || per_cu < 1) { fprintf(stderr, "kernel_launch: occupancy query says %d\n", per_cu); }
        (void)hipGetLastError();
        grid = cus;
    }
    if (grid < 0) return;
    if (hipMemsetAsync((char*)d_ws + WS_CTL, 0, CTL_ZERO_BYTES, stream) != hipSuccess) return;
    Args a{};
    for (int i = 0; i < 14; ++i) a.in[i] = (const float*)d_in[i];
    a.out = (float*)d_out; a.ws = (unsigned char*)d_ws;
#if MK_CUTS == 0
    a.ph_lo = 0; a.ph_hi = N_PHASES; a.li = 0; a.pad = 0;
    hipLaunchKernelGGL(fwd, dim3(grid), dim3(NWAVES * 64), LDS_BYTES, stream, a);
#else
    for (int p = 0; p < N_PHASES; ++p) { a.ph_lo = p; a.ph_hi = p + 1; a.li = p; a.pad = 0; hipLaunchKernelGGL(fwd, dim3(grid), dim3(NWAVES * 64), LDS_BYTES, stream, a); }
#endif
}
```
